# Optimizing an MI355X kernel written in HIP

```python
import jax, jax.numpy as jnp
from jax import lax
import numpy as np

D_MODEL = 1024
BATCH = 32
SEQ = 2048
DEPTH = 1

CONV_WIDTH = D_MODEL
CONV_K = 3
RWKV_HEAD = 64
RWKV_HEADS = D_MODEL // RWKV_HEAD
RWKV_WIDTH = RWKV_HEADS * RWKV_HEAD
DECAY_LORA = 64
AAA_LORA = 64
GATE_LORA = 160
N_EXPERTS = 32
TOP_K = 4
D_FF = D_MODEL
SWIGLU_ALPHA = 1.702
SWIGLU_LIMIT = 7.0
MOE_BLOCK = 256
NORM_EPS = 1e-5
GN_EPS = 64e-5
CONV_COLS = 3 * CONV_WIDTH
RWKV_COLS = 3 * RWKV_WIDTH + DECAY_LORA + AAA_LORA + GATE_LORA
GATE_COLS = 2 * D_MODEL
PROJ_COLS = CONV_COLS + RWKV_COLS + GATE_COLS

kernel_name = "hybrid_conv_rwkv7_moe_block"


def rmsnorm(x, g):
    xf = x.astype(jnp.float32)
    y = xf * lax.rsqrt(jnp.mean(xf * xf, axis=-1, keepdims=True) + NORM_EPS)
    return (y * g.astype(jnp.float32)).astype(x.dtype)


def short_conv_mixer(p, conv_w):
    gb, gc, xin = jnp.split(p, 3, axis=-1)
    u = gc * xin
    s = u.shape[1]
    up = jnp.pad(u, ((0, 0), (CONV_K - 1, 0), (0, 0)))
    conv = sum(conv_w[j] * up[:, j:j + s] for j in range(CONV_K))
    return gb * conv


def rwkv7_time_mix(p, mu, w0, w2, a0, a2, g2, k_k, k_a, r_k, ln_g, ln_b):
    f32 = jnp.float32
    bsz, s, _ = p.shape
    p = p.astype(f32)
    p_prev = jnp.pad(p, ((0, 0), (1, 0), (0, 0)))[:, :-1]
    p = p + (p_prev - p) * mu
    r, k, v, wd, ad, gd = jnp.split(
        p, [RWKV_WIDTH, 2 * RWKV_WIDTH, 3 * RWKV_WIDTH,
            3 * RWKV_WIDTH + DECAY_LORA, 3 * RWKV_WIDTH + DECAY_LORA + AAA_LORA], axis=-1)
    w = -jax.nn.softplus(-(w0 + jnp.tanh(wd) @ w2)) - 0.5
    decay = jnp.exp(-jnp.exp(w))
    a = jax.nn.sigmoid(a0 + ad @ a2)
    g = jax.nn.sigmoid(gd) @ g2
    heads = lambda t: t.reshape(bsz, s, RWKV_HEADS, RWKV_HEAD)
    kk = heads(k * k_k)
    kk = kk / jnp.maximum(jnp.sqrt(jnp.sum(kk * kk, axis=-1, keepdims=True)), 1e-12)
    k = k * (1.0 + (a - 1.0) * k_a)
    r_h, k_h, v_h, w_h, a_h = heads(r), heads(k), heads(v), heads(decay), heads(a)

    def step(state, inp):
        r_t, w_t, k_t, v_t, kk_t, a_t = inp
        sa = jnp.einsum('bhij,bhj->bhi', state, kk_t)
        state = (state * w_t[:, :, None, :]
                 + jnp.einsum('bhi,bhj->bhij', -sa, kk_t * a_t)
                 + jnp.einsum('bhi,bhj->bhij', v_t, k_t))
        return state, jnp.einsum('bhij,bhj->bhi', state, r_t)

    xs = tuple(jnp.moveaxis(t, 1, 0) for t in (r_h, w_h, k_h, v_h, kk, a_h))
    s0 = jnp.zeros((bsz, RWKV_HEADS, RWKV_HEAD, RWKV_HEAD), f32)
    _, y = lax.scan(step, s0, xs)
    y = jnp.moveaxis(y, 0, 1)
    mean = jnp.mean(y, axis=-1, keepdims=True)
    var = jnp.mean(jnp.square(y - mean), axis=-1, keepdims=True)
    y = ((y - mean) * lax.rsqrt(var + GN_EPS)).reshape(bsz, s, RWKV_WIDTH) * ln_g + ln_b
    bonus = (jnp.sum(r_h * k_h * r_k, axis=-1, keepdims=True) * v_h).reshape(bsz, s, RWKV_WIDTH)
    return (y + bonus) * g


def clamped_swiglu(u):
    glu, lin = jnp.split(u, 2, axis=-1)
    glu = jnp.minimum(glu, SWIGLU_LIMIT)
    lin = jnp.clip(lin, -SWIGLU_LIMIT, SWIGLU_LIMIT)
    return glu * jax.nn.sigmoid(SWIGLU_ALPHA * glu) * (lin + 1.0)


def moe_ffn(h, router_w, router_b, w1, b1, w2, b2):
    t, d = h.shape
    logits = (h @ router_w + router_b).astype(jnp.float32)
    top_val, top_idx = lax.top_k(logits, TOP_K)
    gates = jax.nn.softmax(top_val, axis=-1).astype(h.dtype)
    n_assign = t * TOP_K
    flat_e = top_idx.reshape(-1)
    order = jnp.argsort(flat_e)
    sorted_e = flat_e[order]
    counts = jnp.bincount(flat_e, length=N_EXPERTS).astype(jnp.int32)
    padded = (counts + MOE_BLOCK - 1) // MOE_BLOCK * MOE_BLOCK
    start = jnp.cumsum(counts) - counts
    padded_end = jnp.cumsum(padded)
    padded_start = padded_end - padded
    slot_sorted = (padded_start[sorted_e] + jnp.arange(n_assign, dtype=jnp.int32) - start[sorted_e]).astype(jnp.int32)
    slot = jnp.zeros((n_assign,), jnp.int32).at[order].set(slot_sorted)
    n_blocks = -(-n_assign // MOE_BLOCK) + N_EXPERTS
    n_slots = n_blocks * MOE_BLOCK
    slot_token = jnp.full((n_slots,), t, jnp.int32).at[slot].set(
        jnp.arange(n_assign, dtype=jnp.int32) // TOP_K)
    block_expert = jnp.minimum(
        jnp.searchsorted(padded_end, jnp.arange(n_blocks, dtype=jnp.int32) * MOE_BLOCK, side='right'),
        N_EXPERTS - 1)
    h_pad = jnp.concatenate([h, jnp.zeros((1, d), h.dtype)], axis=0)
    xb = h_pad[slot_token].reshape(n_blocks, MOE_BLOCK, d)

    def expert_block(args):
        xblk, e = args
        u = xblk @ w1[e] + b1[e]
        return clamped_swiglu(u) @ w2[e] + b2[e]

    yb = lax.map(expert_block, (xb, block_expert)).reshape(n_slots, d)
    return jnp.einsum('tkd,tk->td', yb[slot].reshape(t, TOP_K, d), gates)


def setup_inputs(seed: int = 0) -> dict:
    key = jax.random.key(seed)
    ks = jax.random.split(key, 24)
    L = DEPTH
    nrm = lambda k, shape, scale: jax.random.normal(k, shape, jnp.float32) * scale
    return {
        "x": nrm(ks[0], (BATCH, SEQ, D_MODEL), 1.0),
        "norm_mix_g": 1.0 + nrm(ks[1], (L, D_MODEL), 0.02),
        "w_in": nrm(ks[2], (L, D_MODEL, PROJ_COLS), D_MODEL ** -0.5),
        "conv_w": nrm(ks[3], (L, CONV_K, CONV_WIDTH), CONV_K ** -0.5),
        "shift_mu": jax.random.uniform(ks[4], (L, RWKV_COLS), jnp.float32),
        "decay_w0": jax.random.uniform(ks[5], (L, RWKV_WIDTH), jnp.float32, minval=-6.0, maxval=-1.0),
        "decay_w2": nrm(ks[6], (L, DECAY_LORA, RWKV_WIDTH), 0.1 * DECAY_LORA ** -0.5),
        "iclr_a0": nrm(ks[7], (L, RWKV_WIDTH), 0.5),
        "iclr_a2": nrm(ks[8], (L, AAA_LORA, RWKV_WIDTH), 0.1 * AAA_LORA ** -0.5),
        "gate_g2": nrm(ks[9], (L, GATE_LORA, RWKV_WIDTH), GATE_LORA ** -0.5),
        "k_k": 0.85 + nrm(ks[10], (L, RWKV_WIDTH), 0.02),
        "k_a": 1.0 + nrm(ks[11], (L, RWKV_WIDTH), 0.02),
        "r_k": nrm(ks[12], (L, RWKV_HEADS, RWKV_HEAD), 0.1),
        "ln_x_g": 1.0 + nrm(ks[13], (L, RWKV_WIDTH), 0.02),
        "ln_x_b": nrm(ks[14], (L, RWKV_WIDTH), 0.01),
        "w_out": nrm(ks[15], (L, D_MODEL, D_MODEL), D_MODEL ** -0.5),
        "norm_ffn_g": 1.0 + nrm(ks[16], (L, D_MODEL), 0.02),
        "router_w": nrm(ks[17], (L, D_MODEL, N_EXPERTS), D_MODEL ** -0.5),
        "router_b": nrm(ks[18], (L, N_EXPERTS), 0.01),
        "exp_w1": nrm(ks[19], (L, N_EXPERTS, D_MODEL, 2 * D_FF), D_MODEL ** -0.5),
        "exp_b1": nrm(ks[20], (L, N_EXPERTS, 2 * D_FF), 0.01),
        "exp_w2": nrm(ks[21], (L, N_EXPERTS, D_FF, D_MODEL), D_FF ** -0.5),
        "exp_b2": nrm(ks[22], (L, N_EXPERTS, D_MODEL), 0.01),
        "norm_final_g": 1.0 + nrm(ks[23], (D_MODEL,), 0.02),
    }


def reference(x, norm_mix_g, w_in, conv_w, shift_mu, decay_w0, decay_w2, iclr_a0, iclr_a2,
              gate_g2, k_k, k_a, r_k, ln_x_g, ln_x_b, w_out, norm_ffn_g, router_w, router_b,
              exp_w1, exp_b1, exp_w2, exp_b2, norm_final_g):
    bsz, s, d = x.shape
    h = x
    for l in range(DEPTH):
        xn = rmsnorm(h, norm_mix_g[l])
        p = xn @ w_in[l]
        p_conv, p_rwkv, p_gate = jnp.split(p, [CONV_COLS, CONV_COLS + RWKV_COLS], axis=-1)
        y_conv = short_conv_mixer(p_conv, conv_w[l])
        y_rwkv = rwkv7_time_mix(p_rwkv, shift_mu[l], decay_w0[l], decay_w2[l], iclr_a0[l],
                                iclr_a2[l], gate_g2[l], k_k[l], k_a[l], r_k[l],
                                ln_x_g[l], ln_x_b[l]).astype(h.dtype)
        gate_conv, gate_rwkv = jnp.split(jax.nn.sigmoid(p_gate), 2, axis=-1)
        h = h + (gate_conv * y_conv + gate_rwkv * y_rwkv) @ w_out[l]
        hn = rmsnorm(h, norm_ffn_g[l]).reshape(bsz * s, d)
        h = h + moe_ffn(hn, router_w[l], router_b[l], exp_w1[l], exp_b1[l],
                        exp_w2[l], exp_b2[l]).reshape(bsz, s, d)
    return rmsnorm(h, norm_final_g)
```

```cpp
#include <hip/hip_runtime.h>
#include <cstdio>
#include <cstdint>

#ifndef ONE_LAUNCH
#define ONE_LAUNCH 1
#endif

#define LAS __attribute__((address_space(3)))
#define GAS __attribute__((address_space(1)))
typedef unsigned short bf16_t;
typedef short bf16x8 __attribute__((ext_vector_type(8)));
typedef long i64x2 __attribute__((ext_vector_type(2)));
typedef float f32x4 __attribute__((ext_vector_type(4)));
typedef float f32x2 __attribute__((ext_vector_type(2)));
typedef float f32x16 __attribute__((ext_vector_type(16)));
typedef unsigned u32x4 __attribute__((ext_vector_type(4)));
typedef unsigned u32x2 __attribute__((ext_vector_type(2)));

constexpr int NB = 32, SEQ = 2048, D = 1024, T = NB * SEQ, NH = 16, HD = 64;
constexpr int PROJ = 8480, NE = 32, TOPK = 4;
constexpr int N1 = 8704;
constexpr int LORA_LD = 512;
constexpr int LISTCAP = T;

constexpr size_t MiB = 1u << 20;
constexpr size_t WS_CTL = 0;
constexpr size_t CTL_ZERO_BYTES = 65536;
constexpr size_t WS_CNT = 65536;
constexpr size_t WS_WINT = 1 * MiB;
constexpr size_t WS_WOUTT = 18 * MiB;
constexpr size_t WS_RWG = 20 * MiB;
constexpr size_t WS_W2T = 20 * MiB + 256 * 1024;
constexpr size_t WS_A2T = WS_W2T + 128 * 1024;
constexpr size_t WS_G2T = WS_A2T + 128 * 1024;
constexpr int LACT_LD = 320;
constexpr size_t WS_R0 = 32 * MiB;
constexpr size_t WS_R1 = 160 * MiB;
constexpr size_t WS_R2 = 288 * MiB;
constexpr size_t WS_R3 = 416 * MiB;
constexpr size_t WS_R4 = 544 * MiB;
constexpr size_t WS_R5 = 672 * MiB;
constexpr size_t WS_R6 = 800 * MiB;
constexpr size_t WS_R7 = 928 * MiB;
constexpr size_t WS_HB = 832 * MiB;
constexpr size_t DO_LACT = 128 * MiB, DO_W2T = 176 * MiB;
constexpr size_t WS_H8 = 448 * MiB;
constexpr size_t WS_RL = 960 * MiB;
constexpr size_t WS_END = 992 * MiB;

constexpr int RING_BYTES = 131072;
constexpr int TAB_OFF = RING_BYTES;
constexpr int LDS_BYTES = 163840;
constexpr int MISC_OFF = LDS_BYTES - 64;

typedef __bf16 bf16x2_t __attribute__((ext_vector_type(2)));
__device__ __forceinline__ unsigned cvt_pk_bf16(float lo, float hi) { const f32x2 v = {lo, hi}; const bf16x2_t r = __builtin_convertvector(v, bf16x2_t); return __builtin_bit_cast(unsigned, r); }
__device__ __forceinline__ unsigned cvt4_fp8(float a, float b, float c, float d) { int w = 0; w = __builtin_amdgcn_cvt_pk_fp8_f32(a, b, w, false); w = __builtin_amdgcn_cvt_pk_fp8_f32(c, d, w, true); return (unsigned)w; }
__device__ __forceinline__ float bf_lo(unsigned w) { return __uint_as_float(w << 16); }
__device__ __forceinline__ float bf_hi(unsigned w) { return __uint_as_float(w & 0xffff0000u); }
__device__ __forceinline__ float bf2f(bf16_t b) { return __uint_as_float(((unsigned)b) << 16); }
__device__ __forceinline__ float fast_rcp(float x) { return __builtin_amdgcn_rcpf(x); }
__device__ __forceinline__ float sigmoidf_(float x) { return fast_rcp(1.0f + __expf(-x)); }
__device__ __forceinline__ float wave_sum(float v) {
#pragma unroll
    for (int o = 1; o < 64; o <<= 1) v += __shfl_xor(v, o);
    return v;
}
template <int CTRL> __device__ __forceinline__ float dpp_mov(float v) { return __int_as_float(__builtin_amdgcn_mov_dpp(__float_as_int(v), CTRL, 0xF, 0xF, true)); }
__device__ __forceinline__ float sum8(float v) { v += dpp_mov<0xB1>(v); v += dpp_mov<0x4E>(v); v += dpp_mov<0x141>(v); return v; }
__device__ __forceinline__ float sum16(float v) { v = sum8(v); v += dpp_mov<0x140>(v); return v; }

__device__ __forceinline__ void unpack8(const u32x4 w, float (&f)[8]) { f[0] = bf_lo(w.x); f[1] = bf_hi(w.x); f[2] = bf_lo(w.y); f[3] = bf_hi(w.y); f[4] = bf_lo(w.z); f[5] = bf_hi(w.z); f[6] = bf_lo(w.w); f[7] = bf_hi(w.w); }

#define XB_TMO      128
#define XB_XCNT(j)  (256  + 64 * (j))
#define XB_XSUB(j)  (1280 + 64 * (j))
#define XB_XGEN(j)  (2304 + 64 * (j))
#define XB_TOP      3328
#define XB_TOPGEN   3392
#define XCD_BAR_WORDS 3456
#define XB_SPIN_CAP (1u << 18)
__device__ __forceinline__ unsigned xb_ld(unsigned* p)              { return __hip_atomic_load(p, __ATOMIC_RELAXED, __HIP_MEMORY_SCOPE_AGENT); }
__device__ __forceinline__ unsigned xb_add(unsigned* p, unsigned v) { return __hip_atomic_fetch_add(p, v, __ATOMIC_RELAXED, __HIP_MEMORY_SCOPE_AGENT); }
__device__ __forceinline__ unsigned xb_xcc_id() { return (unsigned)__builtin_amdgcn_s_getreg((3 << 11) | 20) & 0xFu; }
#define XB_SPIN(cond, bar) do { unsigned _sp = 0; while (cond) { __builtin_amdgcn_s_sleep(1); \
    if ((++_sp & 255u) == 0u) { if (xb_ld(&(bar)[XB_TMO])) break; if (_sp > XB_SPIN_CAP) { atomicAdd(&(bar)[XB_TMO], 1u); break; } } } } while (0)
struct XcdBarrier { unsigned* bar; unsigned x; volatile LAS unsigned* st; };
__device__ __forceinline__ XcdBarrier xcd_barrier_post(unsigned* bar, volatile LAS unsigned* st) {
    XcdBarrier b; b.bar = bar; b.x = xb_xcc_id(); b.st = st;
    if (threadIdx.x == 0) (void)xb_add(&bar[XB_XCNT(b.x)], 1u);
    return b;
}
__device__ __forceinline__ void xcd_barrier_complete(unsigned* bar, unsigned x, unsigned& nloc, unsigned& nx) {
    const unsigned G = gridDim.x * gridDim.y * gridDim.z;
    unsigned sum, cnt, mine, sp = 0u;
    for (;;) {
        sum = 0u; cnt = 0u; mine = 0u;
#pragma unroll
        for (unsigned j = 0; j < 16; ++j) { const unsigned c = xb_ld(&bar[XB_XCNT(j)]); sum += c; cnt += (c > 0u) ? 1u : 0u; mine = (j == x) ? c : mine; }
        if (sum == G) break;
        __builtin_amdgcn_s_sleep(1);
        if ((++sp & 255u) == 0u) { if (xb_ld(&bar[XB_TMO])) break; if (sp > XB_SPIN_CAP) { atomicAdd(&bar[XB_TMO], 1u); break; } }
    }
    nloc = mine > 0u ? mine : 1u; nx = cnt > 0u ? cnt : 1u;
}
__device__ __forceinline__ void xcd_barrier(const XcdBarrier& b) {
    asm volatile("s_waitcnt vmcnt(0)" ::: "memory");
    __syncthreads();
    if (threadIdx.x == 0) {
        unsigned* bar = b.bar;
        __builtin_amdgcn_s_waitcnt(0);
        unsigned nloc = b.st[0], nx = b.st[1];
        if (nloc == 0u) { xcd_barrier_complete(bar, b.x, nloc, nx); b.st[0] = nloc; b.st[1] = nx; }
        const unsigned old = xb_add(&bar[XB_XSUB(b.x)], 1u);
        const unsigned gen = old / nloc;
        if (old + 1u == (gen + 1u) * nloc) {
            __builtin_amdgcn_fence(__ATOMIC_RELEASE, "agent");
            asm volatile("s_waitcnt vmcnt(0)" ::: "memory");
            const unsigned og = xb_add(&bar[XB_TOP], 1u);
            const unsigned tg = og / nx;
            if (og + 1u == (tg + 1u) * nx) xb_add(&bar[XB_TOPGEN], 1u);
            else XB_SPIN(xb_ld(&bar[XB_TOPGEN]) == tg, bar);
            __builtin_amdgcn_fence(__ATOMIC_ACQUIRE, "agent");
            xb_add(&bar[XB_XGEN(b.x)], 1u);
            asm volatile("s_waitcnt vmcnt(0)" ::: "memory");
        } else {
            XB_SPIN(xb_ld(&bar[XB_XGEN(b.x)]) == gen, bar);
            __builtin_amdgcn_fence(__ATOMIC_ACQUIRE, "agent");
            asm volatile("s_waitcnt vmcnt(0)" ::: "memory");
        }
    }
    __syncthreads();
}

namespace pg8 {
constexpr int BM = 256, BK = 64, HALF = 128, HTB = HALF * BK * 2, STAGE_BYTES = 8 * HTB, NXCD = 8, WGM = 8;
__device__ __forceinline__ int lds_byte(int r, int c) { const int st = (r >> 4) * 2 + (c >> 5), rr = r & 15, cc = c & 31, ob = rr * 64 + cc * 2; return st * 1024 + (ob ^ (((ob >> 9) & 1) << 5)); }
__device__ __forceinline__ void stage_rc(int b, int& R, int& C) { const int st = b / 1024, sb = b % 1024, swz = sb ^ (((sb >> 9) & 1) << 5); R = (st >> 1) * 16 + swz / 64; C = (st & 1) * 32 + (swz % 64) / 2; }
__device__ __forceinline__ int perm32(int rho) { const int n = rho >> 4, i = rho & 15; return 8 * (i >> 2) + 4 * n + (i & 3); }

struct Unit { int pm, pn, at, bt, e, rt; };

struct StaticOrder {
    int nM, nN, nwg, G, c;
    __device__ void init(int M, int N, int G_, int c_) { nM = M / BM; nN = N / BM; nwg = nM * nN; G = G_; c = c_; }
    __device__ bool next(int i, Unit& u) const {
        const long L = (long)i * G + c; if (L >= nwg) return false;
        int wgid = (int)L; { const int q = nwg / NXCD, r = nwg % NXCD, xcd = wgid % NXCD, off = wgid / NXCD; wgid = (xcd < r ? xcd * (q + 1) : r * (q + 1) + (xcd - r) * q) + off; }
        const int nig = WGM * nN, gid = wgid / nig, fm = gid * WGM, gsz = (nM - fm) < WGM ? (nM - fm) : WGM;
        u.pm = fm + ((wgid % nig) % gsz); u.pn = (wgid % nig) / gsz; u.at = u.pm; u.bt = u.pn; u.e = 0; u.rt = 0; return true;
    }
    __device__ __forceinline__ int token(const Unit&, int) const { return 0; }
};

template <class Epi, class Sched, bool GATHER>
__device__ __forceinline__ void gemm_phase(LAS unsigned char* lds, const bf16_t* Ag, const bf16_t* Btg, const int K, const Sched& S, const Epi& E) {
    const int tid = threadIdx.x, wid = __builtin_amdgcn_readfirstlane(tid >> 6), lane = tid & 63, wr = wid >> 2, wc = wid & 3, fr = lane & 15, fq = lane >> 4;
    constexpr bool F8 = Epi::F8;
    const int KB = F8 ? K : 2 * K;
    const int nt = KB / (BK * 2);
    unsigned voffA[2], voffB[2];
#pragma unroll
    for (int i = 0; i < 2; ++i) { int R, C; stage_rc(tid * 16 + i * 8192, R, C); const int Rb = Epi::PERM ? ((R & ~31) + perm32(R & 31)) : R;
        voffA[i] = (unsigned)(R * KB + C * 2); voffB[i] = (unsigned)(Rb * KB + C * 2); }
    const size_t kstep = (size_t)(BK * 2);
    const size_t hstep = (size_t)HALF * KB;
    const size_t tstep = 2 * hstep;
    const unsigned ldsw = (unsigned)wid * 1024u;
    const int aoff = lds_byte(wr * 64 + fr, fq * 8), boff = lds_byte(wc * 32 + fr, fq * 8);
#define PG8_SA(b, h) (((b) * 2 + (h)) * HTB)
#define PG8_SB(b, h) ((4 + (b) * 2 + (h)) * HTB)
#define PG8_STAGE(bufoff, gbase, voff) do { _Pragma("unroll") for (int _i = 0; _i < 2; ++_i) \
        __builtin_amdgcn_global_load_lds((const unsigned*)((const char*)(gbase) + (voff)[_i]), (LAS unsigned*)(lds + (bufoff) + ldsw + _i * 8192), 16, 0, 0); } while (0)
#define PG8_STAGE_A(bufoff, NGP, GB, GO) do { if constexpr (GATHER) { PG8_STAGE(bufoff, GB, GO); } else { PG8_STAGE(bufoff, NGP, voffA); } } while (0)
#define PG8_LDA(dst, b, h) do { _Pragma("unroll") for (int m = 0; m < 4; ++m) _Pragma("unroll") for (int k = 0; k < 2; ++k) dst[m][k] = *(const LAS bf16x8*)(lds + PG8_SA(b, h) + aoff + m * 2048 + k * 1024); } while (0)
#define PG8_LDB(dst, b, h) do { _Pragma("unroll") for (int n = 0; n < 2; ++n) _Pragma("unroll") for (int k = 0; k < 2; ++k) dst[n][k] = *(const LAS bf16x8*)(lds + PG8_SB(b, h) + boff + n * 2048 + k * 1024); } while (0)
#define PG8_MMA(ai, bj, At, Bt) do { __builtin_amdgcn_s_setprio(1); _Pragma("unroll") for (int m = 0; m < 4; ++m) _Pragma("unroll") for (int n = 0; n < 2; ++n) _Pragma("unroll") for (int k = 0; k < 2; ++k) { \
        if constexpr (F8) { const i64x2 a_ = __builtin_bit_cast(i64x2, At[m][k]), b_ = __builtin_bit_cast(i64x2, Bt[n][k]);     \
            acc[ai][bj][m][n] = __builtin_amdgcn_mfma_f32_16x16x32_fp8_fp8(b_.x, a_.x, acc[ai][bj][m][n], 0, 0, 0); acc[ai][bj][m][n] = __builtin_amdgcn_mfma_f32_16x16x32_fp8_fp8(b_.y, a_.y, acc[ai][bj][m][n], 0, 0, 0); } \
        else acc[ai][bj][m][n] = __builtin_amdgcn_mfma_f32_16x16x32_bf16(Bt[n][k], At[m][k], acc[ai][bj][m][n], 0, 0, 0); } __builtin_amdgcn_s_setprio(0); } while (0)
#define PG8_WAIT_V(n) asm volatile("s_waitcnt vmcnt(" #n ")" ::: "memory")
#define PG8_WAIT_L(n) asm volatile("s_waitcnt lgkmcnt(" #n ")" ::: "memory")
#define PG8_BAR __builtin_amdgcn_s_barrier()
#define PG8_SCHED __builtin_amdgcn_sched_barrier(0)
#define PG8_GOFFS(u, o) do { _Pragma("unroll") for (int _h = 0; _h < 2; ++_h) _Pragma("unroll") for (int _i = 0; _i < 2; ++_i) { int _R, _C; stage_rc(tid * 16 + _i * 8192, _R, _C); \
        const int _tok = S.token(u, _h * HALF + _R); (o)[_h][_i] = (unsigned)(_tok * KB + _C * 2); } } while (0)
    Unit cur, nxt; int ui = 0;
    if (!S.next(0, cur)) return;
    f32x4 acc[2][2][4][2];
#pragma unroll
    for (int a = 0; a < 2; ++a)
#pragma unroll
        for (int b = 0; b < 2; ++b)
#pragma unroll
            for (int m = 0; m < 4; ++m)
#pragma unroll
                for (int n = 0; n < 2; ++n) acc[a][b][m][n] = (f32x4){0.f, 0.f, 0.f, 0.f};
    bf16x8 At[4][2], B0[2][2], B1[2][2];
    unsigned offC[2][2] = {{0u, 0u}, {0u, 0u}}, offN[2][2] = {{0u, 0u}, {0u, 0u}};
    const char* const Ab = (const char*)Ag;
    const char* cA = Ab + (size_t)cur.at * tstep; const char* cB = (const char*)Btg + (size_t)cur.bt * tstep;
    if constexpr (GATHER) { PG8_GOFFS(cur, offC); }
    PG8_STAGE(PG8_SB(0, 0), cB, voffB); PG8_STAGE(PG8_SB(0, 1), cB + hstep, voffB);
    PG8_STAGE_A(PG8_SA(0, 0), cA, Ab, offC[0]); PG8_STAGE_A(PG8_SA(0, 1), cA + hstep, Ab, offC[1]);
    if (wr == 1) PG8_BAR;
    PG8_WAIT_V(2); PG8_BAR;
    PG8_STAGE(PG8_SB(1, 0), cB + kstep, voffB); PG8_STAGE_A(PG8_SA(1, 0), cA + kstep, Ab + kstep, offC[0]); PG8_STAGE(PG8_SB(1, 1), cB + hstep + kstep, voffB);
    PG8_WAIT_V(6); PG8_BAR;
    for (;;) {
        const bool has_next = S.next(ui + 1, nxt);
        const char* nA = has_next ? Ab + (size_t)nxt.at * tstep : cA; const char* nB = has_next ? (const char*)Btg + (size_t)nxt.bt * tstep : cB;
        if constexpr (GATHER) {
            if (has_next) { PG8_GOFFS(nxt, offN); }
            else { offN[0][0] = offC[0][0]; offN[0][1] = offC[0][1]; offN[1][0] = offC[1][0]; offN[1][1] = offC[1][1]; }
        }
#pragma nounroll
        for (int t = 0; t < nt; t += 2) {
            const bool last = (t == nt - 2);
            const char* a1 = cA + (size_t)(t + 1) * kstep;
            const char* a2 = last ? nA : cA + (size_t)(t + 2) * kstep; const char* b2 = last ? nB : cB + (size_t)(t + 2) * kstep;
            const char* a3 = a2 + kstep; const char* b3 = b2 + kstep;
            const char* g1 = Ab + (size_t)(t + 1) * kstep;
            const char* g2 = last ? Ab : Ab + (size_t)(t + 2) * kstep; const char* g3 = g2 + kstep;
            unsigned s0[2], s1[2];
            s0[0] = last ? offN[0][0] : offC[0][0]; s0[1] = last ? offN[0][1] : offC[0][1];
            s1[0] = last ? offN[1][0] : offC[1][0]; s1[1] = last ? offN[1][1] : offC[1][1];
            PG8_LDB(B0, 0, 0); PG8_LDB(B1, 0, 1); PG8_SCHED; PG8_LDA(At, 0, 0); PG8_STAGE_A(PG8_SA(1, 1), a1 + hstep, g1, offC[1]);
            PG8_WAIT_V(8); PG8_WAIT_L(0); PG8_BAR; PG8_MMA(0, 0, At, B0); PG8_MMA(0, 1, At, B1); PG8_BAR; PG8_SCHED;
            PG8_LDA(At, 0, 1); PG8_STAGE(PG8_SB(0, 0), b2, voffB); PG8_STAGE(PG8_SB(0, 1), b2 + hstep, voffB); PG8_STAGE_A(PG8_SA(0, 0), a2, g2, s0);
            PG8_WAIT_V(8); PG8_WAIT_L(0); PG8_BAR; PG8_MMA(1, 0, At, B0); PG8_MMA(1, 1, At, B1); PG8_BAR; PG8_SCHED;
            PG8_LDB(B0, 1, 0); PG8_LDB(B1, 1, 1); PG8_SCHED; PG8_LDA(At, 1, 0); PG8_STAGE_A(PG8_SA(0, 1), a2 + hstep, g2, s1);
            PG8_WAIT_V(8); PG8_WAIT_L(0); PG8_BAR; PG8_MMA(0, 0, At, B0); PG8_MMA(0, 1, At, B1); PG8_BAR; PG8_SCHED;
            PG8_LDA(At, 1, 1); PG8_STAGE(PG8_SB(1, 0), b3, voffB); PG8_STAGE(PG8_SB(1, 1), b3 + hstep, voffB); PG8_STAGE_A(PG8_SA(1, 0), a3, g3, s0);
            PG8_WAIT_V(8); PG8_WAIT_L(0); PG8_BAR; PG8_MMA(1, 0, At, B0); PG8_MMA(1, 1, At, B1); PG8_BAR; PG8_SCHED;
        }
        if (wr == 0) PG8_BAR;
        E(acc, cur, wr, wc, fr, fq);
        if (!has_next) break;
#pragma unroll
        for (int a = 0; a < 2; ++a)
#pragma unroll
            for (int b = 0; b < 2; ++b)
#pragma unroll
                for (int m = 0; m < 4; ++m)
#pragma unroll
                    for (int n = 0; n < 2; ++n) acc[a][b][m][n] = (f32x4){0.f, 0.f, 0.f, 0.f};
        cur = nxt; cA = nA; cB = nB; ++ui;
        if constexpr (GATHER) { offC[0][0] = offN[0][0]; offC[0][1] = offN[0][1]; offC[1][0] = offN[1][0]; offC[1][1] = offN[1][1]; }
        if (wr == 1) PG8_BAR;
    }
    PG8_WAIT_V(0);
    PG8_BAR;
#undef PG8_SA
#undef PG8_SB
#undef PG8_STAGE
#undef PG8_STAGE_A
#undef PG8_LDA
#undef PG8_LDB
#undef PG8_MMA
#undef PG8_WAIT_V
#undef PG8_WAIT_L
#undef PG8_BAR
#undef PG8_SCHED
#undef PG8_GOFFS
}
}

struct Args {
    const float* in[24];
    float* out;
    unsigned char* ws;
    int ph_lo, ph_hi;
};
enum { I_X = 0, I_NMG, I_WIN, I_CONVW, I_MU, I_W0, I_W2, I_A0, I_A2, I_G2, I_KK, I_KA, I_RK, I_LNG, I_LNB, I_WOUT, I_NFG, I_RW, I_RB, I_EW1, I_EB1, I_EW2, I_EB2, I_NFIN };
enum { PH_PREP = 0, PH_GEMM1, PH_LORA, PH_SCAN, PH_WOUT, PH_ROUTER, PH_MOE_0, PH_MOE_1, PH_MOE_2, PH_MOE_3, PH_MOE_4, PH_FINAL, NPH };

struct Ctx {
    const float* const* in; float* out; unsigned char* ws; LAS unsigned char* lds;
    int tid, lane, wave, G, bid;
};
#define WSP(T_, off) ((T_*)(C.ws + (off)))

__device__ __forceinline__ void transpose_item(const float* W, int ld, int col0, int nvalid, int k0, bf16_t* WTrow0, LAS float* scr, int lane, const float* kscale = nullptr) {
    const int c4 = 4 * (lane & 7), r0 = lane >> 3;
    f32x4 v[8];
#pragma unroll
    for (int i = 0; i < 8; ++i) v[i] = c4 < nvalid ? __builtin_nontemporal_load((const f32x4*)(W + (size_t)(k0 + r0 + 8 * i) * ld + col0 + c4)) : (f32x4){0.f, 0.f, 0.f, 0.f};
    if (kscale) {
#pragma unroll
        for (int i = 0; i < 8; ++i) v[i] *= kscale[k0 + r0 + 8 * i]; }
#pragma unroll
    for (int i = 0; i < 8; ++i) { LAS float* d = scr + (r0 + 8 * i) * 33 + c4; d[0] = v[i].x; d[1] = v[i].y; d[2] = v[i].z; d[3] = v[i].w; }
    asm volatile("s_waitcnt lgkmcnt(0)" ::: "memory");
    const int c = lane & 7;
#pragma unroll
    for (int j = 0; j < 4; ++j) { const int n = (lane >> 3) + 8 * j; const LAS float* s = scr + (8 * c) * 33 + n;
        u32x4 o; o.x = cvt_pk_bf16(s[0 * 33], s[1 * 33]); o.y = cvt_pk_bf16(s[2 * 33], s[3 * 33]); o.z = cvt_pk_bf16(s[4 * 33], s[5 * 33]); o.w = cvt_pk_bf16(s[6 * 33], s[7 * 33]);
        *(u32x4*)(WTrow0 + (size_t)n * 1024 + k0 + 8 * c) = o; }
    asm volatile("s_waitcnt lgkmcnt(0)" ::: "memory");
}
__device__ __forceinline__ void transpose_item_f8(const float* W, int ld, int col0, int k0, unsigned char* WTrow0, LAS float* scr, int lane, float scale, const float* kscale = nullptr) {
    const int c4 = 4 * (lane & 7), r0 = lane >> 3;
    f32x4 v[8];
#pragma unroll
    for (int i = 0; i < 8; ++i) v[i] = __builtin_nontemporal_load((const f32x4*)(W + (size_t)(k0 + r0 + 8 * i) * ld + col0 + c4));
#pragma unroll
    for (int i = 0; i < 8; ++i) { const float sc = kscale ? scale * kscale[k0 + r0 + 8 * i] : scale; LAS float* d = scr + (r0 + 8 * i) * 33 + c4; d[0] = v[i].x * sc; d[1] = v[i].y * sc; d[2] = v[i].z * sc; d[3] = v[i].w * sc; }
    asm volatile("s_waitcnt lgkmcnt(0)" ::: "memory");
    const int c = lane & 7;
#pragma unroll
    for (int j = 0; j < 4; ++j) { const int n = (lane >> 3) + 8 * j; const LAS float* s = scr + (8 * c) * 33 + n;
        u32x2 o; o.x = cvt4_fp8(s[0 * 33], s[1 * 33], s[2 * 33], s[3 * 33]); o.y = cvt4_fp8(s[4 * 33], s[5 * 33], s[6 * 33], s[7 * 33]);
        *(u32x2*)(WTrow0 + (size_t)n * 1024 + k0 + 8 * c) = o; }
    asm volatile("s_waitcnt lgkmcnt(0)" ::: "memory");
}
__device__ __forceinline__ void win_colmap(int np, int& col, int& nvalid) {
    const int pn = np >> 8, bj = (np >> 7) & 1, w = np & 127; nvalid = 32;
    if (pn < 8) col = (bj ? 2048 : 1024) + 128 * pn + w;
    else if (pn < 16) col = (bj ? 0 : 6432) + 128 * (pn - 8) + w;
    else if (pn < 20) col = 7456 + 256 * (pn - 16) + 128 * bj + w;
    else if (pn < 32) col = 3072 + 256 * (pn - 20) + 128 * bj + w;
    else { const int lc = 256 * (pn - 32) + 128 * bj + w; col = 6144 + lc; nvalid = 288 - lc; nvalid = nvalid < 0 ? 0 : (nvalid > 32 ? 32 : nvalid); if (nvalid == 0) col = 0; }
}
__device__ __forceinline__ void rms_row_to_bf16(const float* xrow, const float* g, bf16_t* orow, int lane) {
    const f32x4* xr = (const f32x4*)xrow + lane;
    f32x4 v[4]; float s = 0.f;
#pragma unroll
    for (int j = 0; j < 4; ++j) { v[j] = xr[64 * j]; s += (v[j].x * v[j].x + v[j].y * v[j].y) + (v[j].z * v[j].z + v[j].w * v[j].w); }
    const float rstd = rsqrtf(wave_sum(s) * (1.f / D) + 1e-5f);
    u32x2* o8 = (u32x2*)orow + lane;
#pragma unroll
    for (int j = 0; j < 4; ++j) { const f32x4 gv = ((const f32x4*)g)[lane + 64 * j]; u32x2 o; o.x = cvt_pk_bf16(v[j].x * rstd * gv.x, v[j].y * rstd * gv.y); o.y = cvt_pk_bf16(v[j].z * rstd * gv.z, v[j].w * rstd * gv.w); o8[64 * j] = o; }
}
__device__ __forceinline__ void phase_prep(const Ctx& C) {
    LAS float* scr = (LAS float*)(C.lds + C.wave * 16384);
    const int gw = C.bid * 8 + C.wave, NGW = C.G * 8;
    if (C.bid == 0 && C.tid < 128) WSP(unsigned, WS_CNT)[C.tid] = 0u;
    constexpr int I_IN = (N1 / 32) * 16, I_OUT = (D / 32) * 16;
    for (int it = gw; it < I_IN + I_OUT; it += NGW) {
        if (it < I_IN) { const int nb = it >> 4, kb = it & 15; int col, nv; win_colmap(nb * 32, col, nv);
            transpose_item(C.in[I_WIN], PROJ, col, nv, kb * 64, WSP(bf16_t, WS_WINT) + (size_t)nb * 32 * 1024, scr, C.lane); }
        else { const int r = it - I_IN, nb = r >> 4, kb = r & 15;
            transpose_item(C.in[I_WOUT], D, nb * 32, 32, kb * 64, WSP(bf16_t, WS_WOUTT) + (size_t)nb * 32 * 1024, scr, C.lane); }
    }
    for (int m = gw; m < T; m += 2 * NGW) {
        const int m2 = m + NGW < T ? m + NGW : m;
        const f32x4* xa = (const f32x4*)(C.in[I_X] + (size_t)m * D) + C.lane; const f32x4* xb = (const f32x4*)(C.in[I_X] + (size_t)m2 * D) + C.lane;
        f32x4 va[4], vb[4]; float sa = 0.f, sb = 0.f;
#pragma unroll
        for (int j = 0; j < 4; ++j) { va[j] = __builtin_nontemporal_load(xa + 64 * j); vb[j] = __builtin_nontemporal_load(xb + 64 * j); }
#pragma unroll
        for (int j = 0; j < 4; ++j) { sa += (va[j].x * va[j].x + va[j].y * va[j].y) + (va[j].z * va[j].z + va[j].w * va[j].w); sb += (vb[j].x * vb[j].x + vb[j].y * vb[j].y) + (vb[j].z * vb[j].z + vb[j].w * vb[j].w); }
#pragma unroll
        for (int o = 1; o < 64; o <<= 1) { sa += __shfl_xor(sa, o); sb += __shfl_xor(sb, o); }
        const float ra = rsqrtf(sa * (1.f / D) + 1e-5f), rb = rsqrtf(sb * (1.f / D) + 1e-5f);
        u32x2* oa = (u32x2*)(WSP(bf16_t, WS_R0) + (size_t)m * D) + C.lane; u32x2* ob = (u32x2*)(WSP(bf16_t, WS_R0) + (size_t)m2 * D) + C.lane;
#pragma unroll
        for (int j = 0; j < 4; ++j) { const f32x4 gv = ((const f32x4*)C.in[I_NMG])[C.lane + 64 * j]; u32x2 o;
            o.x = cvt_pk_bf16(va[j].x * ra * gv.x, va[j].y * ra * gv.y); o.y = cvt_pk_bf16(va[j].z * ra * gv.z, va[j].w * ra * gv.w); oa[64 * j] = o;
            o.x = cvt_pk_bf16(vb[j].x * rb * gv.x, vb[j].y * rb * gv.y); o.y = cvt_pk_bf16(vb[j].z * rb * gv.z, vb[j].w * rb * gv.w); ob[64 * j] = o; }
    }
    for (int i = C.bid * 512 + C.tid; i < D * 64; i += C.G * 512) { const int c = i >> 6, k = i & 63;
        WSP(bf16_t, WS_W2T)[i] = (bf16_t)(cvt_pk_bf16(C.in[I_W2][(size_t)k * D + c], 0.f) & 0xffffu); WSP(bf16_t, WS_A2T)[i] = (bf16_t)(cvt_pk_bf16(C.in[I_A2][(size_t)k * D + c], 0.f) & 0xffffu); }
    for (int i = C.bid * 512 + C.tid; i < D * 160; i += C.G * 512) { const int c = i / 160, k = i - c * 160;
        WSP(bf16_t, WS_G2T)[i] = (bf16_t)(cvt_pk_bf16(C.in[I_G2][(size_t)k * D + c], 0.f) & 0xffffu); }
    for (int i = C.bid * 512 + C.tid; i < D * NE; i += C.G * 512) { const int c = i >> 5, e = i & 31; const float v = C.in[I_NFG][c] * C.in[I_RW][i];
        const unsigned hi = cvt_pk_bf16(v, 0.f) & 0xffffu; const float r = v - __uint_as_float(hi << 16); const unsigned lo = cvt_pk_bf16(r, 0.f) & 0xffffu;
        const int o = ((c >> 4) * 32 + e) * 16 + (c & 15); WSP(bf16_t, WS_RWG)[o] = (bf16_t)hi; WSP(bf16_t, WS_RWG)[32768 + o] = (bf16_t)lo; }
}
__device__ __forceinline__ void phase_cvt_experts(const Ctx& C) {
    LAS float* scr = (LAS float*)(C.lds + C.wave * 16384);
    const int gw = C.bid * 8 + C.wave, NGW = C.G * 8;
    constexpr int I_1 = NE * (2048 / 32) * 16, I_2 = NE * (1024 / 32) * 16;
    for (int it = gw; it < I_1 + I_2; it += NGW) {
        if (it < I_1) { const int e = it / (64 * 16), r = it % (64 * 16), nb = r >> 4, kb = r & 15; const int np = nb * 32, pn = np >> 8, bj = (np >> 7) & 1, w = np & 127;
            const int col = (bj ? 1024 : 0) + 128 * pn + w;
            transpose_item_f8(C.in[I_EW1] + (size_t)e * 1024 * 2048, 2048, col, kb * 64, WSP(unsigned char, WS_R0) + ((size_t)e * 2048 + np) * 1024, scr, C.lane, 64.0f, C.in[I_NFG]); }
        else { const int q = it - I_1, e = q / (32 * 16), r = q % (32 * 16), nb = r >> 4, kb = r & 15;
            transpose_item_f8(C.in[I_EW2] + (size_t)e * 1024 * 1024, 1024, nb * 32, kb * 64, (unsigned char*)C.out + DO_W2T + ((size_t)e * 1024 + nb * 32) * 1024, scr, C.lane, 64.0f); }
    }
}

struct EpiP1 {
    static constexpr bool PERM = true, F8 = false;
    unsigned char* ws;
    __device__ __forceinline__ void operator()(const f32x4 (&acc)[2][2][4][2], const pg8::Unit& u, int wr, int wc, int fr, int fq) const {
        const int pn = u.pn, row0 = u.pm * 256 + wr * 64 + fr, cl = wc * 32 + 8 * fq;
        if (pn < 16) {
            bf16_t* O = (bf16_t*)(ws + WS_R1 + (size_t)(pn >> 3) * (128 * MiB)) + 128 * (pn & 7) + cl;
#pragma unroll
            for (int ai = 0; ai < 2; ++ai)
#pragma unroll
                for (int m = 0; m < 4; ++m) {
                    f32x4 a0 = acc[ai][0][m][0], a1 = acc[ai][0][m][1]; const f32x4 b0 = acc[ai][1][m][0], b1 = acc[ai][1][m][1];
                    if (pn >= 8) {
#pragma unroll
                        for (int j = 0; j < 4; ++j) { a0[j] = sigmoidf_(a0[j]); a1[j] = sigmoidf_(a1[j]); }
                    }
                    a0 = a0 * b0; a1 = a1 * b1;
                    u32x4 w; w.x = cvt_pk_bf16(a0[0], a0[1]); w.y = cvt_pk_bf16(a0[2], a0[3]); w.z = cvt_pk_bf16(a1[0], a1[1]); w.w = cvt_pk_bf16(a1[2], a1[3]);
                    __builtin_nontemporal_store(w, (u32x4*)(O + (size_t)(row0 + ai * 128 + m * 16) * D));
                }
        } else {
            int rix, c0, ld = D; const bool sg = pn < 20;
            if (pn < 20) { rix = 3; c0 = 256 * (pn - 16); }
            else if (pn < 32) { const int q = pn - 20; rix = 4 + (q >> 2); c0 = 256 * (q & 3); }
            else { rix = 7; c0 = 256 * (pn - 32); ld = LORA_LD; }
            bf16_t* O = (bf16_t*)(ws + WS_R0 + (size_t)rix * (128 * MiB)) + c0 + cl;
#pragma unroll
            for (int ai = 0; ai < 2; ++ai)
#pragma unroll
                for (int m = 0; m < 4; ++m)
#pragma unroll
                    for (int bj = 0; bj < 2; ++bj) {
                        f32x4 a0 = acc[ai][bj][m][0], a1 = acc[ai][bj][m][1];
                        if (sg) {
#pragma unroll
                            for (int j = 0; j < 4; ++j) { a0[j] = sigmoidf_(a0[j]); a1[j] = sigmoidf_(a1[j]); }
                        }
                        u32x4 w; w.x = cvt_pk_bf16(a0[0], a0[1]); w.y = cvt_pk_bf16(a0[2], a0[3]); w.z = cvt_pk_bf16(a1[0], a1[1]); w.w = cvt_pk_bf16(a1[2], a1[3]);
                        __builtin_nontemporal_store(w, (u32x4*)(O + (size_t)(row0 + ai * 128 + m * 16) * ld + bj * 128));
                    }
        }
    }
};

__device__ __forceinline__ void phase_lact(const Ctx& C) {
    const bf16_t* LORA = WSP(bf16_t, WS_R7); bf16_t* LACT = (bf16_t*)((unsigned char*)C.out + DO_LACT); const float* mu = C.in[I_MU] + 3072;
    constexpr int NI = T * 40, UN = 4; const int S = C.G * 512;
    for (int item0 = C.bid * 512 + C.tid; item0 < NI; item0 += UN * S) {
        u32x4 rc[UN], rp[UN];
#pragma unroll
        for (int q = 0; q < UN; ++q) { const int item = item0 + q * S; rc[q] = (u32x4){0u, 0u, 0u, 0u}; rp[q] = rc[q];
            if (item < NI) { const int t = item / 40, c = (item - t * 40) * 8;
                if (c < 288) { rc[q] = *(const u32x4*)(LORA + (size_t)t * LORA_LD + c); if (t & (SEQ - 1)) rp[q] = *(const u32x4*)(LORA + (size_t)(t - 1) * LORA_LD + c); } } }
#pragma unroll
        for (int q = 0; q < UN; ++q) { const int item = item0 + q * S;
            if (item < NI) { const int t = item / 40, c = (item - t * 40) * 8;
                u32x4 o = {0u, 0u, 0u, 0u};
                if (c < 288) {
                    float cur[8], prev[8], v[8];
                    unpack8(rc[q], cur); unpack8(rp[q], prev);
                    const f32x4 m0 = *(const f32x4*)(mu + c), m1 = *(const f32x4*)(mu + c + 4);
#pragma unroll
                    for (int j = 0; j < 8; ++j) { const float m = j < 4 ? m0[j] : m1[j - 4]; float x = cur[j] + (prev[j] - cur[j]) * m;
                        if (c < 64) x = 1.0f - 2.0f * fast_rcp(1.0f + __expf(2.0f * x));
                        else if (c >= 128) x = sigmoidf_(x);
                        v[j] = x; }
                    o.x = cvt_pk_bf16(v[0], v[1]); o.y = cvt_pk_bf16(v[2], v[3]); o.z = cvt_pk_bf16(v[4], v[5]); o.w = cvt_pk_bf16(v[6], v[7]);
                }
                *(u32x4*)(LACT + (size_t)t * LACT_LD + c) = o; } }
    }
}

namespace mx {
constexpr int SLOT = 9216, ROWB = 144;
constexpr int F32ROWB = 272;
constexpr int G2T_RB = 336, LACT_OFF = 6 * SLOT, LACT_RB = 656;
constexpr int HBS = 12;
constexpr int SM_BON = 13 * SLOT, SM_GC = SM_BON + 256, SM_CST = SM_GC + 256;
constexpr int PW2T_OFF = SM_CST + 12 * 256, PA2T_OFF = PW2T_OFF + SLOT, PG2T_OFF = PA2T_OFF + SLOT;
static_assert(LACT_OFF + 64 * LACT_RB <= 11 * SLOT, "staging area");
constexpr int SM_C1 = PG2T_OFF + 64 * G2T_RB, SM_CNV = SM_C1 + 256;
static_assert(SM_CNV + 16 <= MISC_OFF, "mixer LDS map");
struct SrcLds { LAS const unsigned char* base; __device__ __forceinline__ bf16x8 operator()(int row, int s, int hh) const { return *(const LAS bf16x8*)(base + row * ROWB + (16 * s + 8 * hh) * 2); } };
template <int RB> struct SrcLdsR { LAS const unsigned char* base; __device__ __forceinline__ bf16x8 operator()(int row, int s, int hh) const { return *(const LAS bf16x8*)(base + row * RB + (16 * s + 8 * hh) * 2); } };
typedef short s16x4 __attribute__((ext_vector_type(4)));
struct SrcLdsT { LAS const unsigned char* base; __device__ __forceinline__ bf16x8 operator()(int, int s, int) const {
        const s16x4 lo = __builtin_amdgcn_ds_read_tr16_b64_v4i16((LAS s16x4*)(base + s * (16 * ROWB))), hi = __builtin_amdgcn_ds_read_tr16_b64_v4i16((LAS s16x4*)(base + s * (16 * ROWB) + 4 * ROWB));
        return __builtin_shufflevector(lo, hi, 0, 1, 2, 3, 4, 5, 6, 7); } };
struct SrcRegs { bf16x8 f[4]; __device__ __forceinline__ bf16x8 operator()(int, int s, int) const { return f[s]; } };
__device__ __forceinline__ SrcRegs preload(LAS const unsigned char* base, int row, int hh) { SrcRegs r;
#pragma unroll
    for (int s = 0; s < 4; ++s) r.f[s] = *(const LAS bf16x8*)(base + row * ROWB + (16 * s + 8 * hh) * 2);
    return r; }
template <bool TRI> struct SrcGen {
    __device__ __forceinline__ bf16x8 operator()(int row, int s, int hh) const { const int k0 = 16 * s + 8 * hh; unsigned w[4];
#pragma unroll
        for (int j = 0; j < 4; ++j) { const int ka = k0 + 2 * j, kb = ka + 1; const bool a = TRI ? (ka <= row) : (ka == row), b = TRI ? (kb <= row) : (kb == row); w[j] = (a ? 0x3F80u : 0u) | (b ? 0x3F800000u : 0u); }
        const u32x4 v = {w[0], w[1], w[2], w[3]}; return __builtin_bit_cast(bf16x8, v); } };
template <int KS, class PS, class QS>
__device__ __forceinline__ f32x16 mm(f32x16 acc, const PS& P, const QS& Q, int prow, int qrow, int hh) {
#pragma unroll
    for (int s = 0; s < KS; ++s) { const bf16x8 a = Q(qrow, s, hh), b = P(prow, s, hh); acc = __builtin_amdgcn_mfma_f32_32x32x16_bf16(a, b, acc, 0, 0, 0); }
    return acc;
}
__device__ __forceinline__ f32x16 zero16() { f32x16 z;
#pragma unroll
    for (int q = 0; q < 16; ++q) z[q] = 0.f;
    return z; }
__device__ __forceinline__ f32x4 quad(const f32x16& a, int q4) { return (f32x4){a[4 * q4], a[4 * q4 + 1], a[4 * q4 + 2], a[4 * q4 + 3]}; }
__device__ __forceinline__ void st_bf4(LAS unsigned char* slot, int p, int q0, f32x4 v) { u32x2 w; w.x = cvt_pk_bf16(v.x, v.y); w.y = cvt_pk_bf16(v.z, v.w); *(LAS u32x2*)(slot + p * ROWB + q0 * 2) = w; }
__device__ __forceinline__ f32x4 ld_bf4(LAS const unsigned char* slot, int p, int q0) { const u32x2 w = *(const LAS u32x2*)(slot + p * ROWB + q0 * 2); return (f32x4){bf_lo(w.x), bf_hi(w.x), bf_lo(w.y), bf_hi(w.y)}; }
template <int MODE> __device__ __forceinline__ f32x4 mask4(f32x4 v, int p, int q0) {
    if (MODE == 0) return v;
#pragma unroll
    for (int e = 0; e < 4; ++e) { const int q = q0 + e; const bool keep = MODE == 1 ? (q < p) : (MODE == 2 ? (q <= p) : (q > p)); v[e] = keep ? v[e] : 0.f; }
    return v;
}
__device__ __forceinline__ void unpack4p(const u32x4 w, f32x2 (&p)[4]) { p[0] = (f32x2){bf_lo(w.x), bf_hi(w.x)}; p[1] = (f32x2){bf_lo(w.y), bf_hi(w.y)}; p[2] = (f32x2){bf_lo(w.z), bf_hi(w.z)}; p[3] = (f32x2){bf_lo(w.w), bf_hi(w.w)}; }
__device__ __forceinline__ unsigned cvt_pk2(f32x2 v) { const bf16x2_t r = __builtin_convertvector(v, bf16x2_t); return __builtin_bit_cast(unsigned, r); }
__device__ __forceinline__ f32x2 exp2p(f32x2 v) { return (f32x2){__builtin_amdgcn_exp2f(v.x), __builtin_amdgcn_exp2f(v.y)}; }
__device__ __forceinline__ f32x2 rcpp(f32x2 v) { return (f32x2){fast_rcp(v.x), fast_rcp(v.y)}; }
__device__ __forceinline__ f32x2 splat2(float x) { return (f32x2){x, x}; }
}

__device__ __forceinline__ void phase_mixer(const Ctx& C) {
    using namespace mx;
    const int tid = C.tid, lane = C.lane, grp = C.wave >> 2, w4 = C.wave & 3, wp = w4 >> 1, wq = w4 & 1, r = lane & 31, hh = lane >> 5;
    int prow = 32 * wp + r, qrow = 32 * wq + r;
    int te = tid >> 3, jo = tid & 7;
    const int trl = (8 * hh + ((lane & 15) >> 2)) * ROWB + 8 * (lane & 3); int trP = trl + 2 * (prow & ~15), trQ = trl + 2 * (qrow & ~15);
    LAS unsigned char* const L = C.lds;
#define SL(k) (L + (k) * SLOT)
#define MX_BAR() do { asm volatile("s_waitcnt lgkmcnt(0)\n\ts_barrier" ::: "memory"); } while (0)
#define MX_OPAQUE() do { asm volatile("" : "+v"(prow), "+v"(qrow), "+v"(trP), "+v"(trQ), "+v"(te), "+v"(jo)); } while (0)
#define MM_STORE_G() do { const f32x16 acc_ = mm<10>(zero16(), ACTG, G2T, prow, qrow, hh); _Pragma("unroll") for (int q4 = 0; q4 < 4; ++q4) st_bf4(SL(5), prow, 32 * wq + 8 * q4 + 4 * hh, quad(acc_, q4)); } while (0)
    LAS float* const BON = (LAS float*)(L + SM_BON); LAS float* const GCV = (LAS float*)(L + SM_GC); LAS unsigned* const CNV = (LAS unsigned*)(L + SM_CNV);
    const bf16_t* Rg = WSP(bf16_t, WS_R4); const bf16_t* Kg = WSP(bf16_t, WS_R5); const bf16_t* Vg = WSP(bf16_t, WS_R6);
    const bf16_t* LACT = (const bf16_t*)((const unsigned char*)C.out + DO_LACT); bf16_t* Yg = (bf16_t*)C.out;
    const bf16_t* Ug = WSP(bf16_t, WS_R1); const bf16_t* GBg = WSP(bf16_t, WS_R2); const bf16_t* GRg = WSP(bf16_t, WS_R3);
    const SrcGen<true> TRI{};
    for (int pair = C.bid; pair < NB * NH; pair += C.G) {
        const int b = pair >> 4, h = pair & 15, cbase = h * HD;
        const bf16_t* const gW2T = WSP(bf16_t, WS_W2T) + (size_t)cbase * 64; const bf16_t* const gA2T = WSP(bf16_t, WS_A2T) + (size_t)cbase * 64; const bf16_t* const gG2T = WSP(bf16_t, WS_G2T) + (size_t)cbase * 160;
        const SrcLdsR<ROWB> W2T{L + PW2T_OFF}, A2T{L + PA2T_OFF}; const SrcLdsR<G2T_RB> G2T{L + PG2T_OFF};
        const SrcLdsR<LACT_RB> ACTW{L + LACT_OFF}, ACTA{L + LACT_OFF + 128}, ACTG{L + LACT_OFF + 256};
        f32x16 Keep = zero16();
        { LAS float* cst = (LAS float*)(L + SM_CST); const int a = tid >> 6, j = tid & 63;
          const float* src = a == 0 ? C.in[I_MU] : a == 1 ? C.in[I_MU] + 1024 : a == 2 ? C.in[I_MU] + 2048 : a == 3 ? C.in[I_KK] : a == 4 ? C.in[I_KA] : a == 5 ? C.in[I_RK] : a == 6 ? C.in[I_LNG] : C.in[I_LNB];
          cst[tid] = src[cbase + j];
          if (tid < 128) cst[512 + tid] = -1.44269504f * (tid < 64 ? C.in[I_W0][cbase + tid] : C.in[I_A0][cbase + tid - 64]);
          else if (tid < 320) { const int tp = (tid - 128) >> 6; const float cw = C.in[I_CONVW][tp * D + cbase + j];
              if (tp == 1) ((LAS float*)(L + SM_C1))[j] = cw; else cst[(tp == 0 ? 640 : 704) + j] = cw; } }
        for (int i = tid; i < SLOT / 16; i += 512) ((LAS u32x4*)SL(HBS))[i] = (u32x4){0u, 0u, 0u, 0u};
        { const bf16_t* gr_ = gG2T + (size_t)te * 160 + jo * 8; LAS unsigned char* lr_ = L + PG2T_OFF + te * G2T_RB + jo * 16;
          const u32x4 w0_ = *(const u32x4*)(gW2T + (size_t)te * 64 + jo * 8), w1_ = *(const u32x4*)(gA2T + (size_t)te * 64 + jo * 8), g0_ = *(const u32x4*)gr_, g1_ = *(const u32x4*)(gr_ + 64);
          *(LAS u32x4*)(L + PW2T_OFF + te * ROWB + jo * 16) = w0_; *(LAS u32x4*)(L + PA2T_OFF + te * ROWB + jo * 16) = w1_; *(LAS u32x4*)lr_ = g0_; *(LAS u32x4*)(lr_ + 128) = g1_;
          if (jo < 4) { const u32x4 g2_ = *(const u32x4*)(gr_ + 128); *(LAS u32x4*)(lr_ + 256) = g2_; }
          asm volatile("" ::: "memory"); }
        u32x4 pf[5];
#define PF_LOAD(tok0_) do { const bf16_t* pg_ = LACT + (size_t)((tok0_) + te) * LACT_LD + jo * 8; _Pragma("unroll") for (int k = 0; k < 5; ++k) pf[k] = __builtin_nontemporal_load((const u32x4*)(pg_ + 64 * k)); } while (0)
        PF_LOAD(b * SEQ);
#define PF_STORE() do { _Pragma("unroll") for (int k = 0; k < 5; ++k) *(LAS u32x4*)(L + LACT_OFF + te * LACT_RB + jo * 16 + 128 * k) = pf[k]; asm volatile("" ::: "memory"); } while (0)
        PF_STORE();
        size_t ga = (size_t)(b * SEQ + te) * D + cbase + 8 * jo;
        u32x4 rR = *(const u32x4*)(Rg + ga), rK = *(const u32x4*)(Kg + ga), rV = *(const u32x4*)(Vg + ga);
        u32x4 rRp = {0u, 0u, 0u, 0u}, rKp = rRp, rVp = rRp;
        if (te > 0) { rRp = *(const u32x4*)(Rg + ga - D); rKp = *(const u32x4*)(Kg + ga - D); rVp = *(const u32x4*)(Vg + ga - D); }
        MX_BAR();
        for (int ch = 0; ch < SEQ / 64; ++ch) {
            MX_OPAQUE();
            const int tok0 = b * SEQ + ch * 64;
            if (grp == 0) { const f32x16 acc = mm<4>(zero16(), ACTA, A2T, prow, qrow, hh);
#pragma unroll
                for (int q4 = 0; q4 < 4; ++q4) { const int q0 = 32 * wq + 8 * q4 + 4 * hh; f32x4 v = quad(acc, q4); const f32x4 a0 = *(const LAS f32x4*)(L + SM_CST + (9 * 64 + q0) * 4);
#pragma unroll
                    for (int e = 0; e < 4; ++e) v[e] = fast_rcp(1.0f + __builtin_amdgcn_exp2f(__builtin_fmaf(v[e], -1.44269504f, a0[e])));
                    st_bf4(SL(4), prow, q0, v); } }
            else { const f32x16 acc = mm<4>(zero16(), ACTW, W2T, prow, qrow, hh);
#pragma unroll
                for (int q4 = 0; q4 < 4; ++q4) { const int q0 = 32 * wq + 8 * q4 + 4 * hh; f32x4 v = quad(acc, q4); const f32x4 w0 = *(const LAS f32x4*)(L + SM_CST + (8 * 64 + q0) * 4);
#pragma unroll
                    for (int e = 0; e < 4; ++e) v[e] = fast_rcp(__builtin_fmaf(__builtin_amdgcn_exp2f(__builtin_fmaf(v[e], -1.44269504f, w0[e])), -1.64872127f, -1.64872127f));
                    st_bf4(SL(1), prow, q0, v); } }
            MX_BAR();
            if (grp == 0) { int pz = prow; asm volatile("" : "+v"(pz)); const f32x16 acc = mm<4>(zero16(), TRI, SrcLdsT{SL(1) + trQ}, pz, qrow, hh);
#pragma unroll
                for (int q4 = 0; q4 < 4; ++q4) *(LAS f32x4*)(SL(2) + prow * F32ROWB + (32 * wq + 8 * q4 + 4 * hh) * 4) = quad(acc, q4); }
            else MM_STORE_G();
            MX_BAR();
            f32x2 vs[4];
            const u32x4 gpk = *(const LAS u32x4*)(SL(5) + te * ROWB + jo * 16);
            {
                const LAS float* cst = (const LAS float*)(L + SM_CST) + 8 * jo;
#define CSTP(a_, dst) do { const f32x4 x0_ = *(const LAS f32x4*)(cst + 64 * (a_)), x1_ = *(const LAS f32x4*)(cst + 64 * (a_) + 4); dst[0] = (f32x2){x0_.x, x0_.y}; dst[1] = (f32x2){x0_.z, x0_.w}; dst[2] = (f32x2){x1_.x, x1_.y}; dst[3] = (f32x2){x1_.z, x1_.w}; } while (0)
#define STP(slot, o) do { u32x4 w_; w_.x = cvt_pk2(o[0]); w_.y = cvt_pk2(o[1]); w_.z = cvt_pk2(o[2]); w_.w = cvt_pk2(o[3]); *(LAS u32x4*)(SL(slot) + te * ROWB + jo * 16) = w_; } while (0)
                f32x2 rr[4], kx[4], tmp[4], cc[4];
                unpack4p(rV, vs); unpack4p(rVp, tmp); CSTP(2, cc);
#pragma unroll
                for (int i = 0; i < 4; ++i) vs[i] = vs[i] + (tmp[i] - vs[i]) * cc[i];
                STP(11, vs);
                unpack4p(rR, rr); unpack4p(rRp, tmp); CSTP(0, cc);
#pragma unroll
                for (int i = 0; i < 4; ++i) rr[i] = rr[i] + (tmp[i] - rr[i]) * cc[i];
                unpack4p(rK, kx); unpack4p(rKp, tmp); CSTP(1, cc);
#pragma unroll
                for (int i = 0; i < 4; ++i) kx[i] = kx[i] + (tmp[i] - kx[i]) * cc[i];
                f32x2 kk[4], av[4]; f32x2 ss2 = splat2(0.f), bn2 = splat2(0.f);
                CSTP(3, cc);
#pragma unroll
                for (int i = 0; i < 4; ++i) { kk[i] = kx[i] * cc[i]; ss2 = ss2 + kk[i] * kk[i]; }
                unpack4p(*(const LAS u32x4*)(SL(4) + te * ROWB + jo * 16), av); CSTP(4, cc);
#pragma unroll
                for (int i = 0; i < 4; ++i) kx[i] = kx[i] * (splat2(1.0f) + (av[i] - splat2(1.0f)) * cc[i]);
                CSTP(5, cc);
#pragma unroll
                for (int i = 0; i < 4; ++i) bn2 = bn2 + rr[i] * kx[i] * cc[i];
                const float ss = sum8(ss2.x + ss2.y), bn = sum8(bn2.x + bn2.y);
                const f32x2 inv = splat2(fminf(__builtin_amdgcn_rsqf(ss), 1e12f));
                if (jo == 0) BON[te] = bn;
                if (tid == 0) *(LAS u32x4*)CNV = (u32x4){0u, 0u, 0u, 0u};
                f32x2 cm[4], ex[4]; const f32x2 L2E = splat2(1.44269504f);
                { const f32x4 c0 = *(const LAS f32x4*)(SL(2) + te * F32ROWB + jo * 32), c1 = *(const LAS f32x4*)(SL(2) + te * F32ROWB + jo * 32 + 16);
                  cm[0] = (f32x2){c0.x, c0.y}; cm[1] = (f32x2){c0.z, c0.w}; cm[2] = (f32x2){c1.x, c1.y}; cm[3] = (f32x2){c1.z, c1.w}; }
                unpack4p(*(const LAS u32x4*)(SL(1) + te * ROWB + jo * 16), tmp);
#pragma unroll
                for (int i = 0; i < 4; ++i) { kk[i] = kk[i] * inv; ex[i] = kk[i] * exp2p((cm[i] - tmp[i]) * L2E); }
                STP(5, ex);
#pragma unroll
                for (int i = 0; i < 4; ++i) { kk[i] = kk[i] * av[i]; cm[i] = exp2p(cm[i] * L2E); ex[i] = rr[i] * cm[i]; }
                STP(8, ex);
                if (te == 63) { *(LAS f32x4*)(GCV + 8 * jo) = (f32x4){cm[0].x, cm[0].y, cm[1].x, cm[1].y}; *(LAS f32x4*)(GCV + 8 * jo + 4) = (f32x4){cm[2].x, cm[2].y, cm[3].x, cm[3].y}; }
#pragma unroll
                for (int i = 0; i < 4; ++i) { const f32x2 ri = rcpp(cm[i]); ex[i] = kx[i] * ri; kk[i] = kk[i] * ri; }
                STP(6, ex);
                STP(7, kk);
            }
            MX_BAR();
#define MM_STORE(dst, PS_, QS_) do { const f32x16 acc_ = mm<4>(zero16(), PS_, QS_, prow, qrow, hh); _Pragma("unroll") for (int q4 = 0; q4 < 4; ++q4) st_bf4(SL(dst), prow, 32 * wq + 8 * q4 + 4 * hh, quad(acc_, q4)); } while (0)
#define MM_STORE_MASK(dst, MODE_, PS_, QS_) do { const f32x16 acc_ = mm<4>(zero16(), PS_, QS_, prow, qrow, hh); _Pragma("unroll") for (int q4 = 0; q4 < 4; ++q4) { const int q0_ = 32 * wq + 8 * q4 + 4 * hh; st_bf4(SL(dst), prow, q0_, mask4<MODE_>(quad(acc_, q4), prow, q0_)); } } while (0)
            f32x16 z0;
            const u32x4 mU0 = *(const u32x4*)(Ug + ga), mGB = __builtin_nontemporal_load((const u32x4*)(GBg + ga)), mGR = __builtin_nontemporal_load((const u32x4*)(GRg + ga));
            u32x4 mU1 = {0u, 0u, 0u, 0u}, mU2 = mU1;
            if (ch > 0 || te >= 1) mU1 = *(const u32x4*)(Ug + ga - D);
            if (ch > 0 || te >= 2) mU2 = *(const u32x4*)(Ug + ga - 2 * D);
            if (grp == 0) { const SrcRegs KKp = preload(SL(5), prow, hh), Bq = preload(SL(7), qrow, hh);
                MM_STORE_MASK(0, 1, KKp, SrcLds{SL(6)});
                MM_STORE_MASK(1, 1, KKp, Bq);
                MM_STORE_MASK(4, 2, SrcLds{SL(8)}, Bq);
            } else { const SrcRegs Rp = preload(SL(8), prow, hh);
                MM_STORE_MASK(3, 2, Rp, SrcLds{SL(6)});
                z0 = mm<4>(zero16(), SrcLds{SL(HBS)}, SrcLds{SL(5)}, prow, qrow, hh);
                Keep = mm<4>(zero16(), Rp, SrcLds{SL(HBS)}, prow, qrow, hh);
            }
            MX_BAR();
            if (grp == 0) MM_STORE(9, SrcLds{SL(1)}, SrcLdsT{SL(1) + trQ});
            else { z0 = mm<4>(z0, SrcLdsT{SL(11) + trP}, SrcLds{SL(0)}, prow, qrow, hh);
#pragma unroll
                for (int q4 = 0; q4 < 4; ++q4) st_bf4(SL(10), prow, 32 * wq + 8 * q4 + 4 * hh, quad(z0, q4)); }
            MX_BAR();
            PF_LOAD(tok0 + (ch + 1 < SEQ / 64 ? 64 : 0));
            if (grp == 0) { const f32x16 acc = mm<4>(zero16(), SrcLds{SL(1)}, SrcLdsT{SL(9) + trQ}, prow, qrow, hh);
#pragma unroll
                for (int q4 = 0; q4 < 4; ++q4) { const int q0 = 32 * wq + 8 * q4 + 4 * hh; f32x4 v = ld_bf4(SL(9), prow, q0) - ld_bf4(SL(1), prow, q0) - quad(acc, q4);
#pragma unroll
                    for (int e = 0; e < 4; ++e) v[e] += (q0 + e == prow) ? 1.0f : 0.0f;
                    st_bf4(SL(8), prow, q0, v); } }
            else MM_STORE(5, SrcLds{SL(9)}, SrcLdsT{SL(9) + trQ});
            MX_BAR();
#define T_UPDATE(dst, tsrc, msrc) do { const f32x16 acc_ = mm<4>(zero16(), SrcLds{SL(tsrc)}, SrcLdsT{SL(msrc) + trQ}, prow, qrow, hh); _Pragma("unroll") for (int q4 = 0; q4 < 4; ++q4) { const int q0_ = 32 * wq + 8 * q4 + 4 * hh; st_bf4(SL(dst), prow, q0_, ld_bf4(SL(tsrc), prow, q0_) + quad(acc_, q4)); } } while (0)
#define MSQ(dst, src, lvl) do { const f32x16 acc_ = mm<4>(zero16(), SrcLds{SL(src)}, SrcLdsT{SL(src) + trQ}, prow, qrow, hh); float mx_ = 0.f; \
                _Pragma("unroll") for (int q4 = 0; q4 < 4; ++q4) st_bf4(SL(dst), prow, 32 * wq + 8 * q4 + 4 * hh, quad(acc_, q4)); \
                _Pragma("unroll") for (int q = 0; q < 16; ++q) mx_ = fmaxf(mx_, fabsf(acc_[q])); \
                mx_ = fmaxf(mx_, dpp_mov<0xB1>(mx_)); mx_ = fmaxf(mx_, dpp_mov<0x4E>(mx_)); mx_ = fmaxf(mx_, dpp_mov<0x141>(mx_)); mx_ = fmaxf(mx_, dpp_mov<0x140>(mx_)); \
                if ((lane & 15) == 0) atomicMax((unsigned*)(CNV + (lvl)), __float_as_uint(mx_)); } while (0)
#define CONVERGED(lvl) (__builtin_amdgcn_readfirstlane((int)(*(volatile LAS unsigned*)(CNV + (lvl)) < 0x39000000u)) != 0)
            if (grp == 0) T_UPDATE(2, 8, 5);
            else { MSQ(0, 5, 0); Keep = mm<4>(Keep, SrcLds{SL(3)}, SrcLdsT{SL(11) + trQ}, prow, qrow, hh); }
            MX_BAR();
            int ts = 2;
            if (!CONVERGED(0)) {
                if (grp == 0) T_UPDATE(8, 2, 0); else MSQ(5, 0, 1);
                MX_BAR();
                ts = 8;
                if (!CONVERGED(1)) {
                    if (grp == 0) T_UPDATE(2, 8, 5); else MSQ(0, 5, 2);
                    MX_BAR();
                    ts = 2;
                    if (!CONVERGED(2)) {
                        if (grp == 0) T_UPDATE(8, 2, 0);
                        MX_BAR();
                        ts = 8;
                    }
                }
            }
            if (grp == 0) Keep = mm<4>(Keep, SrcLdsT{SL(11) + trP}, SrcLdsT{SL(6) + trQ}, prow, qrow, hh);
            else { const f32x16 acc = mm<4>(zero16(), SrcLds{SL(10)}, SrcLds{SL(ts)}, prow, qrow, hh);
#pragma unroll
                for (int q4 = 0; q4 < 4; ++q4) st_bf4(SL(9), prow, 32 * wq + 8 * q4 + 4 * hh, -quad(acc, q4)); }
            MX_BAR();
            if (grp == 0) { Keep = mm<4>(Keep, SrcLds{SL(9)}, SrcLdsT{SL(7) + trQ}, prow, qrow, hh);
#pragma unroll
                for (int q4 = 0; q4 < 4; ++q4) { const f32x4 gc = *(const LAS f32x4*)(GCV + 32 * wq + 8 * q4 + 4 * hh);
#pragma unroll
                    for (int e = 0; e < 4; ++e) Keep[4 * q4 + e] *= gc[e]; } }
            else { Keep = mm<4>(Keep, SrcLds{SL(4)}, SrcLds{SL(9)}, prow, qrow, hh);
#pragma unroll
                for (int q4 = 0; q4 < 4; ++q4) *(LAS f32x4*)(SL(0) + prow * F32ROWB + (32 * wq + 8 * q4 + 4 * hh) * 4) = quad(Keep, q4); }
            MX_BAR();
            {
                const size_t gy = ga;
                PF_STORE();
                if (ch + 1 < SEQ / 64) ga += (size_t)64 * D;
                rR = *(const u32x4*)(Rg + ga); rK = *(const u32x4*)(Kg + ga); rV = *(const u32x4*)(Vg + ga);
                rRp = *(const u32x4*)(Rg + ga - D); rKp = *(const u32x4*)(Kg + ga - D); rVp = *(const u32x4*)(Vg + ga - D);
                const f32x4 y0 = *(const LAS f32x4*)(SL(0) + te * F32ROWB + jo * 32), y1 = *(const LAS f32x4*)(SL(0) + te * F32ROWB + jo * 32 + 16);
                f32x2 y[4] = {(f32x2){y0.x, y0.y}, (f32x2){y0.z, y0.w}, (f32x2){y1.x, y1.y}, (f32x2){y1.z, y1.w}}, gg[4];
                unpack4p(gpk, gg);
                const f32x2 sm2 = (y[0] + y[1]) + (y[2] + y[3]);
                const f32x2 mean = splat2(sum8(sm2.x + sm2.y) * (1.0f / 64.0f)); f32x2 sv2 = splat2(0.f);
#pragma unroll
                for (int i = 0; i < 4; ++i) { y[i] = y[i] - mean; sv2 = sv2 + y[i] * y[i]; }
                const f32x2 rstd = splat2(__builtin_amdgcn_rsqf(sum8(sv2.x + sv2.y) * (1.0f / 64.0f) + 64e-5f)), bo = splat2(BON[te]);
                const LAS float* cst = (const LAS float*)(L + SM_CST) + 8 * jo; f32x2 lg_[4], lb_[4]; CSTP(6, lg_); CSTP(7, lb_);
                f32x2 o[4];
#pragma unroll
                for (int i = 0; i < 4; ++i) o[i] = (y[i] * rstd * lg_[i] + lb_[i] + bo * vs[i]) * gg[i];
                { f32x2 u[4], cv[4], tp[4];
                  unpack4p(mU2, u); CSTP(10, tp);
#pragma unroll
                  for (int i = 0; i < 4; ++i) cv[i] = tp[i] * u[i];
                  unpack4p(mU1, u); { const f32x4 x0_ = *(const LAS f32x4*)(L + SM_C1 + 32 * jo), x1_ = *(const LAS f32x4*)(L + SM_C1 + 32 * jo + 16); tp[0] = (f32x2){x0_.x, x0_.y}; tp[1] = (f32x2){x0_.z, x0_.w}; tp[2] = (f32x2){x1_.x, x1_.y}; tp[3] = (f32x2){x1_.z, x1_.w}; }
#pragma unroll
                  for (int i = 0; i < 4; ++i) cv[i] = cv[i] + tp[i] * u[i];
                  unpack4p(mU0, u); CSTP(11, tp);
#pragma unroll
                  for (int i = 0; i < 4; ++i) cv[i] = cv[i] + tp[i] * u[i];
                  unpack4p(mGB, u); unpack4p(mGR, tp);
#pragma unroll
                  for (int i = 0; i < 4; ++i) o[i] = u[i] * cv[i] + tp[i] * o[i]; }
                u32x4 w; w.x = cvt_pk2(o[0]); w.y = cvt_pk2(o[1]); w.z = cvt_pk2(o[2]); w.w = cvt_pk2(o[3]);
                *(u32x4*)(Yg + gy) = w;
                if (grp == 0) {
#pragma unroll
                    for (int q4 = 0; q4 < 4; ++q4) st_bf4(SL(HBS), prow, 32 * wq + 8 * q4 + 4 * hh, quad(Keep, q4)); }
            }
            MX_BAR();
        }
    }
#undef SL
#undef MX_BAR
#undef STP
#undef CSTP
#undef MM_STORE
#undef T_UPDATE
#undef MM_STORE_G
#undef MM_STORE_MASK
#undef MSQ
#undef CONVERGED
#undef PF_LOAD
#undef PF_STORE
}

struct EpiWout {
    static constexpr bool PERM = true, F8 = false;
    const float* x; bf16_t* h; unsigned char* h8;
    __device__ __forceinline__ void load_q(f32x4 (&xv)[2][2][2], int q, int row0, int col0) const {
#pragma unroll
        for (int mm = 0; mm < 2; ++mm) { const size_t off = (size_t)(row0 + (q >> 1) * 128 + ((q & 1) * 2 + mm) * 16) * D + col0;
#pragma unroll
            for (int bj = 0; bj < 2; ++bj) { xv[mm][bj][0] = __builtin_nontemporal_load((const f32x4*)(x + off + bj * 128)); xv[mm][bj][1] = __builtin_nontemporal_load((const f32x4*)(x + off + bj * 128 + 4)); } }
    }
    __device__ __forceinline__ void store_q(const f32x4 (&xv)[2][2][2], const f32x4 (&acc)[2][2][4][2], int q, int row0, int col0) const {
        const int ai = q >> 1;
#pragma unroll
        for (int mm = 0; mm < 2; ++mm) { const int m = (q & 1) * 2 + mm; const size_t off = (size_t)(row0 + ai * 128 + m * 16) * D + col0;
#pragma unroll
            for (int bj = 0; bj < 2; ++bj) { const f32x4 v0 = xv[mm][bj][0] + acc[ai][bj][m][0], v1 = xv[mm][bj][1] + acc[ai][bj][m][1];
                u32x4 w; w.x = cvt_pk_bf16(v0[0], v0[1]); w.y = cvt_pk_bf16(v0[2], v0[3]); w.z = cvt_pk_bf16(v1[0], v1[1]); w.w = cvt_pk_bf16(v1[2], v1[3]);
                *(u32x4*)(h + off + bj * 128) = w;
                u32x2 w8; w8.x = cvt4_fp8(v0[0], v0[1], v0[2], v0[3]); w8.y = cvt4_fp8(v1[0], v1[1], v1[2], v1[3]); *(u32x2*)(h8 + off + bj * 128) = w8; } }
    }
    __device__ __forceinline__ void operator()(const f32x4 (&acc)[2][2][4][2], const pg8::Unit& u, int wr, int wc, int fr, int fq) const {
        const int row0 = u.pm * 256 + wr * 64 + fr, col0 = u.pn * 256 + wc * 32 + 8 * fq;
        f32x4 xa[2][2][2], xb[2][2][2];
        load_q(xa, 0, row0, col0); load_q(xb, 1, row0, col0);
        store_q(xa, acc, 0, row0, col0); load_q(xa, 2, row0, col0);
        store_q(xb, acc, 1, row0, col0); load_q(xb, 3, row0, col0);
        store_q(xa, acc, 2, row0, col0);
        store_q(xb, acc, 3, row0, col0);
    }
};

__device__ __forceinline__ void split8(const f32x4 a, const f32x4 b, bf16x8& hi, bf16x8& lo) {
    float f[8] = {a.x, a.y, a.z, a.w, b.x, b.y, b.z, b.w}; unsigned h[4], l[4];
#pragma unroll
    for (int j = 0; j < 4; ++j) { h[j] = cvt_pk_bf16(f[2 * j], f[2 * j + 1]); l[j] = cvt_pk_bf16(f[2 * j] - bf_lo(h[j]), f[2 * j + 1] - bf_hi(h[j])); }
    const u32x4 hv = {h[0], h[1], h[2], h[3]}, lv = {l[0], l[1], l[2], l[3]};
    hi = __builtin_bit_cast(bf16x8, hv); lo = __builtin_bit_cast(bf16x8, lv);
}
__device__ __forceinline__ void phase_router(const Ctx& C) {
    LAS unsigned char* WL = C.lds;
    LAS unsigned* lcnt = (LAS unsigned*)(C.lds + TAB_OFF); LAS unsigned* lbase = lcnt + 128; LAS unsigned short* lent = (LAS unsigned short*)(lbase + 128);
    const bf16_t* hbuf = WSP(bf16_t, WS_HB); float* RL = WSP(float, WS_RL); float* GL = (float*)C.out; LAS float* lrstd = (LAS float*)(lent + 1024); LAS float* lgate = lrstd + 256;
    unsigned* gcnt = WSP(unsigned, WS_CNT); int* LIST = WSP(int, WS_R6);
    const float* rb = C.in[I_RB];
    const int lane = C.lane, r = lane & 31, hh = lane >> 5;
    { const u32x4* src = WSP(const u32x4, WS_RWG) + C.tid; u32x4 t[16];
#pragma unroll
      for (int i = 0; i < 16; ++i) t[i] = src[512 * i];
#pragma unroll
      for (int i = 0; i < 16; ++i) ((LAS u32x4*)WL)[C.tid + 512 * i] = t[i]; }
    __syncthreads();
    for (int blk = C.bid; blk < T / 256; blk += C.G) {
        if (C.tid < 128) lcnt[C.tid] = 0u;
        __syncthreads();
        const int t = blk * 256 + C.wave * 32 + r;
        const u32x4* hp = (const u32x4*)(hbuf + (size_t)t * D) + hh;
        f32x16 acc;
#pragma unroll
        for (int q = 0; q < 16; ++q) acc[q] = 0.f;
        float ss = 0.f;
#pragma unroll 8
        for (int s = 0; s < 64; ++s) {
            const u32x4 tv = hp[2 * s]; float f[8]; unpack8(tv, f);
#pragma unroll
            for (int j = 0; j < 8; ++j) ss += f[j] * f[j];
            const bf16x8 th = __builtin_bit_cast(bf16x8, tv);
            const bf16x8 whi = *(const LAS bf16x8*)(WL + s * 1024 + r * 32 + hh * 16), wlo = *(const LAS bf16x8*)(WL + 65536 + s * 1024 + r * 32 + hh * 16);
            acc = __builtin_amdgcn_mfma_f32_32x32x16_bf16(whi, th, acc, 0, 0, 0);
            acc = __builtin_amdgcn_mfma_f32_32x32x16_bf16(wlo, th, acc, 0, 0, 0);
        }
        ss += __shfl_xor(ss, 32);
        const float rstd = rsqrtf(ss * (1.f / D) + 1e-5f);
        float lg[32];
#pragma unroll
        for (int q = 0; q < 16; ++q) { const float mine = acc[q], other = __shfl_xor(mine, 32); const int e0 = (q & 3) + 8 * (q >> 2);
            lg[e0 + 4 * hh] = mine; lg[e0 + 4 * (hh ^ 1)] = other; }
#pragma unroll
        for (int e = 0; e < 32; ++e) lg[e] = lg[e] * rstd + rb[e];
        int ti[4]; float tv[4];
#pragma unroll
        for (int k = 0; k < 4; ++k) { float best = -3.0e38f; int bi = 0;
#pragma unroll
            for (int e = 0; e < 32; ++e) { const bool take = lg[e] > best; best = take ? lg[e] : best; bi = take ? e : bi; }
            ti[k] = bi; tv[k] = best;
#pragma unroll
            for (int e = 0; e < 32; ++e) lg[e] = (e == bi) ? -3.0e38f : lg[e]; }
        const float e1 = __expf(tv[1] - tv[0]), e2 = __expf(tv[2] - tv[0]), e3 = __expf(tv[3] - tv[0]); const float inv = 1.0f / (1.0f + e1 + e2 + e3);
        if (hh == 0) {
            const int tl = C.wave * 32 + r;
            *(LAS f32x4*)(lgate + tl * 4) = (f32x4){inv, e1 * inv, e2 * inv, e3 * inv};
#pragma unroll
            for (int k = 0; k < 4; ++k) { const unsigned pos = atomicAdd((unsigned*)&lcnt[k * 32 + ti[k]], 1u); lent[tl * 4 + k] = (unsigned short)(((unsigned)ti[k] << 8) | pos); }
            lrstd[tl] = rstd;
        }
        __syncthreads();
        if (C.tid < 128) { const unsigned n = lcnt[C.tid]; lbase[C.tid] = n ? __hip_atomic_fetch_add(&gcnt[C.tid], n, __ATOMIC_RELAXED, __HIP_MEMORY_SCOPE_AGENT) : 0u; }
        __syncthreads();
        for (int idx = C.tid; idx < 1024; idx += 512) { const int tl = idx >> 2, k = idx & 3; const unsigned ent = lent[idx], e = ent >> 8, pos = ent & 0xffu;
            const size_t li = (size_t)(k * 32 + e) * LISTCAP + lbase[k * 32 + e] + pos; LIST[li] = blk * 256 + tl; RL[li] = lrstd[tl]; GL[li] = lgate[idx]; }
        __syncthreads();
    }
}

struct MoeSched {
    int G, c, NT, n_tiles;     const LAS int* tstart; const LAS int* texp; const LAS unsigned* cnt; const int* list;
    __device__ __forceinline__ bool next(int i, pg8::Unit& u) const {
        const int L = i * G + c, tile = L / NT; if (tile >= n_tiles) return false;
        u.pn = L - tile * NT; u.e = texp[tile]; u.rt = tile - tstart[u.e]; u.pm = tile; u.at = tile; u.bt = u.e * NT + u.pn; return true;
    }
    __device__ __forceinline__ int token(const pg8::Unit& u, int row) const { const int idx = u.rt * 256 + row; return list[(size_t)u.e * LISTCAP + (idx < (int)cnt[u.e] ? idx : 0)]; }
};
__device__ __forceinline__ void moe_tables(const Ctx& C, int k, MoeSched& S, int NT, int set, int rot) {
    LAS int* tstart = (LAS int*)(C.lds + TAB_OFF + set * 2048); LAS unsigned* cnt = (LAS unsigned*)(C.lds + TAB_OFF + set * 2048 + 160); LAS int* texp = (LAS int*)(C.lds + TAB_OFF + set * 2048 + 320);
    const unsigned* gcnt = WSP(unsigned, WS_CNT);
    __syncthreads();
    if (C.tid < 32) cnt[C.tid] = gcnt[k * 32 + C.tid];
    __syncthreads();
    if (C.tid < 64) {
        const int e = C.tid, n = e < 32 ? ((int)cnt[e & 31] + 255) >> 8 : 0; int incl = n;
#pragma unroll
        for (int o = 1; o < 32; o <<= 1) { const int t = __shfl_up(incl, o); if (e >= o) incl += t; }
        if (e < 32) { const int a = incl - n; tstart[e] = a; for (int j = 0; j < n; ++j) texp[a + j] = e; if (e == 31) tstart[32] = incl; }
    }
    __syncthreads();
    { const int vcu = (C.G % 8 == 0) ? (C.bid % 8) * (C.G / 8) + C.bid / 8 : C.bid;
      S.G = C.G; S.c = (vcu + rot) % C.G; S.NT = NT; } S.n_tiles = tstart[32]; S.tstart = tstart; S.texp = texp; S.cnt = cnt; S.list = WSP(int, WS_R6) + (size_t)k * 32 * LISTCAP;
}
struct EpiMoeA {
    static constexpr bool PERM = true, F8 = true;
    unsigned char* ACT; const float* b1; const float* rl; const LAS unsigned* cnt;
    __device__ __forceinline__ void operator()(const f32x4 (&acc)[2][2][4][2], const pg8::Unit& u, int wr, int wc, int fr, int fq) const {
        const int row0 = u.pm * 256 + wr * 64 + fr, cl = 128 * u.pn + wc * 32 + 8 * fq;
        const float* bg = b1 + (size_t)u.e * 2048 + cl; f32x4 bgl[2], bln[2];
#pragma unroll
        for (int n = 0; n < 2; ++n) { bgl[n] = *(const f32x4*)(bg + 4 * n); bln[n] = *(const f32x4*)(bg + 1024 + 4 * n); }
        float rs[2][4]; const int n_e = (int)cnt[u.e];
#pragma unroll
        for (int ai = 0; ai < 2; ++ai)
#pragma unroll
            for (int m = 0; m < 4; ++m) { const int idx = u.rt * 256 + ai * 128 + wr * 64 + m * 16 + fr; rs[ai][m] = rl[(size_t)u.e * LISTCAP + (idx < n_e ? idx : 0)] * 0.015625f; }
#pragma unroll
        for (int ai = 0; ai < 2; ++ai)
#pragma unroll
            for (int m = 0; m < 4; ++m) { f32x4 o[2];
#pragma unroll
                for (int n = 0; n < 2; ++n) { const f32x4 gl = acc[ai][0][m][n] * rs[ai][m] + bgl[n], ln = acc[ai][1][m][n] * rs[ai][m] + bln[n];
#pragma unroll
                    for (int j = 0; j < 4; j += 2) {
                        const f32x2 gv = (f32x2){fminf(gl[j], 7.0f), fminf(gl[j + 1], 7.0f)}, lv = (f32x2){fminf(fmaxf(ln[j], -7.0f), 7.0f), fminf(fmaxf(ln[j + 1], -7.0f), 7.0f)};
                        const f32x2 t = gv * (f32x2){-2.45546696f, -2.45546696f};
                        const f32x2 e = (f32x2){__builtin_amdgcn_exp2f(t.x), __builtin_amdgcn_exp2f(t.y)} + (f32x2){1.0f, 1.0f};
                        const f32x2 sg = (f32x2){fast_rcp(e.x), fast_rcp(e.y)};
                        const f32x2 r = (gv * sg) * (lv + (f32x2){1.0f, 1.0f});
                        o[n][j] = r.x; o[n][j + 1] = r.y; } }
                u32x2 w; w.x = cvt4_fp8(o[0][0], o[0][1], o[0][2], o[0][3]); w.y = cvt4_fp8(o[1][0], o[1][1], o[1][2], o[1][3]);
                *(u32x2*)(ACT + (size_t)(row0 + ai * 128 + m * 16) * D + cl) = w; }
    }
};
struct EpiMoeB {
    static constexpr bool PERM = true, F8 = true;
    const bf16_t* hs; bf16_t* h; const float* b2; const float* gl; const int* list; const LAS unsigned* cnt;
    __device__ __forceinline__ void operator()(const f32x4 (&acc)[2][2][4][2], const pg8::Unit& u, int wr, int wc, int fr, int fq) const {
        const int col0 = u.pn * 256 + wc * 32 + 8 * fq; const int n_e = (int)cnt[u.e];
        int tok[2][4]; float gt[2][4];
#pragma unroll
        for (int ai = 0; ai < 2; ++ai)
#pragma unroll
            for (int m = 0; m < 4; ++m) { const int idx = u.rt * 256 + ai * 128 + wr * 64 + m * 16 + fr; const size_t li = (size_t)u.e * LISTCAP + (idx < n_e ? idx : 0); tok[ai][m] = list[li]; const float g = gl[li]; gt[ai][m] = idx < n_e ? g : -1.0f; }
        f32x4 bv[2][2];
#pragma unroll
        for (int bj = 0; bj < 2; ++bj)
#pragma unroll
            for (int n = 0; n < 2; ++n) bv[bj][n] = *(const f32x4*)(b2 + (size_t)u.e * D + col0 + bj * 128 + 4 * n);
#define MB_LOAD(hv, q) do { _Pragma("unroll") for (int mm = 0; mm < 2; ++mm) _Pragma("unroll") for (int bj = 0; bj < 2; ++bj) \
            hv[mm][bj] = *(const u32x4*)(hs + (size_t)tok[(q) >> 1][((q) & 1) * 2 + mm] * D + col0 + bj * 128); } while (0)
#define MB_STORE(hv, q) do { _Pragma("unroll") for (int mm = 0; mm < 2; ++mm) { const int ai = (q) >> 1, m = ((q) & 1) * 2 + mm; if (gt[ai][m] > 0.f) { bf16_t* hp = h + (size_t)tok[ai][m] * D + col0; \
            _Pragma("unroll") for (int bj = 0; bj < 2; ++bj) { float f[8]; unpack8(hv[mm][bj], f); const f32x4 d0 = (acc[ai][bj][m][0] * 0.015625f + bv[bj][0]) * gt[ai][m], d1 = (acc[ai][bj][m][1] * 0.015625f + bv[bj][1]) * gt[ai][m]; \
                u32x4 w; w.x = cvt_pk_bf16(f[0] + d0[0], f[1] + d0[1]); w.y = cvt_pk_bf16(f[2] + d0[2], f[3] + d0[3]); w.z = cvt_pk_bf16(f[4] + d1[0], f[5] + d1[1]); w.w = cvt_pk_bf16(f[6] + d1[2], f[7] + d1[3]); \
                *(u32x4*)(hp + bj * 128) = w; } } } } while (0)
        u32x4 ha[2][2], hb[2][2];
        MB_LOAD(ha, 0); MB_LOAD(hb, 1);
        MB_STORE(ha, 0); MB_LOAD(ha, 2);
        MB_STORE(hb, 1); MB_LOAD(hb, 3);
        MB_STORE(ha, 2);
        MB_STORE(hb, 3);
#undef MB_LOAD
#undef MB_STORE
    }
};

__device__ __forceinline__ void phase_final(const Ctx& C) {
    const int gw = C.bid * 8 + C.wave, NGW = C.G * 8; const float* g = C.in[I_NFIN]; const bf16_t* hb = WSP(bf16_t, WS_R1);
    for (int m = gw; m < T; m += 2 * NGW) {
        const int m2 = m + NGW < T ? m + NGW : m;
        const u32x2* xa = (const u32x2*)(hb + (size_t)m * D) + C.lane; const u32x2* xb = (const u32x2*)(hb + (size_t)m2 * D) + C.lane;
        u32x2 wa[4], wb[4];
#pragma unroll
        for (int j = 0; j < 4; ++j) { wa[j] = xa[64 * j]; wb[j] = xb[64 * j]; }
        f32x4 va[4], vb[4]; float sa = 0.f, sb = 0.f;
#pragma unroll
        for (int j = 0; j < 4; ++j) { va[j] = (f32x4){bf_lo(wa[j].x), bf_hi(wa[j].x), bf_lo(wa[j].y), bf_hi(wa[j].y)}; vb[j] = (f32x4){bf_lo(wb[j].x), bf_hi(wb[j].x), bf_lo(wb[j].y), bf_hi(wb[j].y)};
            sa += (va[j].x * va[j].x + va[j].y * va[j].y) + (va[j].z * va[j].z + va[j].w * va[j].w); sb += (vb[j].x * vb[j].x + vb[j].y * vb[j].y) + (vb[j].z * vb[j].z + vb[j].w * vb[j].w); }
#pragma unroll
        for (int o = 1; o < 64; o <<= 1) { sa += __shfl_xor(sa, o); sb += __shfl_xor(sb, o); }
        const float ra = rsqrtf(sa * (1.f / D) + 1e-5f), rb = rsqrtf(sb * (1.f / D) + 1e-5f);
        f32x4* oa = (f32x4*)(C.out + (size_t)m * D) + C.lane; f32x4* ob = (f32x4*)(C.out + (size_t)m2 * D) + C.lane;
#pragma unroll
        for (int j = 0; j < 4; ++j) { const f32x4 gv = ((const f32x4*)g)[C.lane + 64 * j]; __builtin_nontemporal_store(va[j] * ra * gv, oa + 64 * j); __builtin_nontemporal_store(vb[j] * rb * gv, ob + 64 * j); }
    }
}

__global__ void __launch_bounds__(512, 2) fwd(Args args) {
    extern __shared__ __attribute__((aligned(16))) unsigned char lds_raw[];
    Ctx C; C.in = args.in; C.out = args.out; C.ws = args.ws; C.lds = (LAS unsigned char*)lds_raw;
    C.tid = threadIdx.x; C.lane = C.tid & 63; C.wave = __builtin_amdgcn_readfirstlane(C.tid >> 6); C.G = gridDim.x; C.bid = blockIdx.x;
    volatile LAS unsigned* MISC = (volatile LAS unsigned*)(C.lds + MISC_OFF);
    if (C.tid < 4) MISC[C.tid] = 0u;
    __syncthreads();
    const int lo = args.ph_lo, hi = args.ph_hi;
    XcdBarrier bar; bar.bar = (unsigned*)(C.ws + WS_CTL); bar.x = 0; bar.st = MISC;
    if (hi - lo > 1) bar = xcd_barrier_post((unsigned*)(C.ws + WS_CTL), MISC);
#define IN(k) (lo <= (k) && (k) < hi)
#define SEAM(k) do { if (IN(k) && IN((k) + 1)) xcd_barrier(bar); } while (0)

    if (IN(PH_PREP)) { phase_prep(C); } SEAM(PH_PREP);

    if (IN(PH_GEMM1)) {
        pg8::StaticOrder S; S.init(T, N1, C.G, C.bid);
        EpiP1 E{C.ws};
        pg8::gemm_phase<EpiP1, pg8::StaticOrder, false>(C.lds, WSP(bf16_t, WS_R0), WSP(bf16_t, WS_WINT), D, S, E);
    } SEAM(PH_GEMM1);

    if (IN(PH_LORA)) { phase_lact(C); phase_cvt_experts(C); } SEAM(PH_LORA);

    if (IN(PH_SCAN)) { phase_mixer(C); } SEAM(PH_SCAN);


    if (IN(PH_WOUT)) {
        pg8::StaticOrder S; S.init(T, D, C.G, C.bid);
        EpiWout E{C.in[I_X], WSP(bf16_t, WS_HB), WSP(unsigned char, WS_H8)};
        pg8::gemm_phase<EpiWout, pg8::StaticOrder, false>(C.lds, (const bf16_t*)C.out, WSP(bf16_t, WS_WOUTT), D, S, E);
    } SEAM(PH_WOUT);

    if (IN(PH_ROUTER)) { phase_router(C); } SEAM(PH_ROUTER);

#define ACT_BUF(kk) (WSP(unsigned char, WS_R2) + (size_t)((kk) & 1) * (76 * MiB))
#define MOE_A(kk, set, rot) do { MoeSched S; moe_tables(C, kk, S, 8, set, rot); EpiMoeA E{ACT_BUF(kk), C.in[I_EB1], WSP(float, WS_RL) + (size_t)(kk) * 32 * LISTCAP, S.cnt}; \
        pg8::gemm_phase<EpiMoeA, MoeSched, true>(C.lds, WSP(bf16_t, WS_H8), WSP(bf16_t, WS_R0), D, S, E); } while (0)
#define MOE_B(kk, set, rotv) do { MoeSched S; moe_tables(C, kk, S, 4, set, 0); EpiMoeB E{(kk) == 0 ? WSP(bf16_t, WS_HB) : WSP(bf16_t, WS_R1), WSP(bf16_t, WS_R1), C.in[I_EB2], (const float*)C.out + (size_t)(kk) * 32 * LISTCAP, S.list, S.cnt}; \
        pg8::gemm_phase<EpiMoeB, MoeSched, false>(C.lds, (const bf16_t*)ACT_BUF(kk), (const bf16_t*)((const unsigned char*)C.out + DO_W2T), D, S, E); rotv = C.G - (S.n_tiles * 4) % C.G; } while (0)
    if (IN(PH_MOE_0)) { MOE_A(0, 0, 0); } SEAM(PH_MOE_0);
    if (IN(PH_MOE_1)) { int rot = 0; MOE_B(0, 0, rot); MOE_A(1, 1, rot); } SEAM(PH_MOE_1);
    if (IN(PH_MOE_2)) { int rot = 0; MOE_B(1, 0, rot); MOE_A(2, 1, rot); } SEAM(PH_MOE_2);
    if (IN(PH_MOE_3)) { int rot = 0; MOE_B(2, 0, rot); MOE_A(3, 1, rot); } SEAM(PH_MOE_3);
    if (IN(PH_MOE_4)) { int rot = 0; MOE_B(3, 0, rot); (void)rot; } SEAM(PH_MOE_4);

    if (IN(PH_FINAL)) { phase_final(C); }
#undef IN
#undef SEAM
}

extern "C" void kernel_launch(void* const* d_in, const int* in_sizes, int n_in, void* d_out, int out_size, void* d_ws, size_t ws_size, hipStream_t stream) {
    static int grid = 0;
    if (grid == 0) {
        if (n_in != 24 || in_sizes[0] != T * D || out_size != T * D || ws_size < WS_END) { fprintf(stderr, "kernel_launch: unexpected shapes (n_in %d, in0 %d, out %d, ws %zu)\n", n_in, n_in > 0 ? in_sizes[0] : -1, out_size, ws_size); grid = -1; return; }
        int dev = 0, cus = 0, per_cu = 0;
        if (hipGetDevice(&dev) != hipSuccess || hipDeviceGetAttribute(&cus, hipDeviceAttributeMultiprocessorCount, dev) != hipSuccess) { grid = -1; return; }
        if (hipFuncSetAttribute((const void*)fwd, hipFuncAttributeMaxDynamicSharedMemorySize, LDS_BYTES) != hipSuccess) { fprintf(stderr, "kernel_launch: hipFuncSetAttribute failed\n"); grid = -1; return; }
        if (hipOccupancyMaxActiveBlocksPerMultiprocessor(&per_cu, (const void*)fwd, 512, LDS_BYTES) != hipSuccess || per_cu < 1) fprintf(stderr, "kernel_launch: occupancy query says %d\n", per_cu);
        (void)hipGetLastError();
        grid = cus;
    }
    if (grid < 0) return;
    (void)hipMemsetAsync((char*)d_ws + WS_CTL, 0, CTL_ZERO_BYTES, stream);
    Args a{};
    for (int i = 0; i < 24; ++i) a.in[i] = (const float*)d_in[i];
    a.out = (float*)d_out; a.ws = (unsigned char*)d_ws;
#if ONE_LAUNCH
    a.ph_lo = 0; a.ph_hi = NPH;
    hipLaunchKernelGGL(fwd, dim3(grid), dim3(512), LDS_BYTES, stream, a);
#else
    for (int p = 0; p < NPH; ++p) { a.ph_lo = p; a.ph_hi = p + 1; hipLaunchKernelGGL(fwd, dim3(grid), dim3(512), LDS_BYTES, stream, a); }
#endif
}
```

```cpp
#include <hip/hip_runtime.h>
#include <cstdio>
#include <cstdint>

#ifndef ONE_LAUNCH
#define ONE_LAUNCH 1
#endif

#define LAS __attribute__((address_space(3)))
#define GAS __attribute__((address_space(1)))
typedef unsigned short bf16_t;
typedef short bf16x8 __attribute__((ext_vector_type(8)));
typedef long i64x2 __attribute__((ext_vector_type(2)));
typedef float f32x4 __attribute__((ext_vector_type(4)));
typedef float f32x2 __attribute__((ext_vector_type(2)));
typedef float f32x16 __attribute__((ext_vector_type(16)));
typedef unsigned u32x4 __attribute__((ext_vector_type(4)));
typedef unsigned u32x2 __attribute__((ext_vector_type(2)));

constexpr int NB = 32, SEQ = 2048, D = 1024, T = NB * SEQ, NH = 16, HD = 64;
constexpr int PROJ = 8480, NE = 32, TOPK = 4;
constexpr int N1 = 8704;
constexpr int LORA_LD = 512;
constexpr int LISTCAP = T;

constexpr size_t MiB = 1u << 20;
constexpr size_t WS_CTL = 0;
constexpr size_t CTL_ZERO_BYTES = 65536;
constexpr size_t WS_CNT = 65536;
constexpr size_t WS_WINT = 1 * MiB;
constexpr size_t WS_WOUTT = 18 * MiB;
constexpr size_t WS_RWG = 20 * MiB;
constexpr size_t WS_W2T = 20 * MiB + 256 * 1024;
constexpr size_t WS_A2T = WS_W2T + 128 * 1024;
constexpr size_t WS_G2T = WS_A2T + 128 * 1024;
constexpr int LACT_LD = 320;
constexpr size_t WS_R0 = 32 * MiB;
constexpr size_t WS_R1 = 160 * MiB;
constexpr size_t WS_R2 = 288 * MiB;
constexpr size_t WS_R3 = 416 * MiB;
constexpr size_t WS_R4 = 544 * MiB;
constexpr size_t WS_R5 = 672 * MiB;
constexpr size_t WS_R6 = 800 * MiB;
constexpr size_t WS_R7 = 928 * MiB;
constexpr size_t WS_HB = 832 * MiB;
constexpr int F8LO = 8, NF8 = 20;
constexpr size_t DO_XN8 = 0, DO_WIN8 = 64 * MiB;
constexpr size_t DO_LACT = 128 * MiB, DO_W2T = 176 * MiB;
constexpr size_t WS_H8 = 448 * MiB;
constexpr size_t WS_RL = 960 * MiB;
constexpr size_t WS_END = 992 * MiB;

constexpr int RING_BYTES = 131072;
constexpr int TAB_OFF = RING_BYTES;
constexpr int LDS_BYTES = 163840;
constexpr int MISC_OFF = LDS_BYTES - 64;

typedef __bf16 bf16x2_t __attribute__((ext_vector_type(2)));
__device__ __forceinline__ unsigned cvt_pk_bf16(float lo, float hi) { const f32x2 v = {lo, hi}; const bf16x2_t r = __builtin_convertvector(v, bf16x2_t); return __builtin_bit_cast(unsigned, r); }
__device__ __forceinline__ unsigned cvt4_fp8(float a, float b, float c, float d) { int w = 0; w = __builtin_amdgcn_cvt_pk_fp8_f32(a, b, w, false); w = __builtin_amdgcn_cvt_pk_fp8_f32(c, d, w, true); return (unsigned)w; }
__device__ __forceinline__ float bf_lo(unsigned w) { return __uint_as_float(w << 16); }
__device__ __forceinline__ float bf_hi(unsigned w) { return __uint_as_float(w & 0xffff0000u); }
__device__ __forceinline__ float bf2f(bf16_t b) { return __uint_as_float(((unsigned)b) << 16); }
__device__ __forceinline__ float fast_rcp(float x) { return __builtin_amdgcn_rcpf(x); }
__device__ __forceinline__ float sigmoidf_(float x) { return fast_rcp(1.0f + __expf(-x)); }
__device__ __forceinline__ float wave_sum(float v) {
#pragma unroll
    for (int o = 1; o < 64; o <<= 1) v += __shfl_xor(v, o);
    return v;
}
template <int CTRL> __device__ __forceinline__ float dpp_mov(float v) { return __int_as_float(__builtin_amdgcn_mov_dpp(__float_as_int(v), CTRL, 0xF, 0xF, true)); }
__device__ __forceinline__ float sum8(float v) { v += dpp_mov<0xB1>(v); v += dpp_mov<0x4E>(v); v += dpp_mov<0x141>(v); return v; }
__device__ __forceinline__ float sum16(float v) { v = sum8(v); v += dpp_mov<0x140>(v); return v; }

__device__ __forceinline__ void unpack8(const u32x4 w, float (&f)[8]) { f[0] = bf_lo(w.x); f[1] = bf_hi(w.x); f[2] = bf_lo(w.y); f[3] = bf_hi(w.y); f[4] = bf_lo(w.z); f[5] = bf_hi(w.z); f[6] = bf_lo(w.w); f[7] = bf_hi(w.w); }

#define XB_TMO      128
#define XB_XCNT(j)  (256  + 64 * (j))
#define XB_XSUB(j)  (1280 + 64 * (j))
#define XB_XGEN(j)  (2304 + 64 * (j))
#define XB_TOP      3328
#define XB_TOPGEN   3392
#define XCD_BAR_WORDS 3456
#define XB_SPIN_CAP (1u << 18)
__device__ __forceinline__ unsigned xb_ld(unsigned* p)              { return __hip_atomic_load(p, __ATOMIC_RELAXED, __HIP_MEMORY_SCOPE_AGENT); }
__device__ __forceinline__ unsigned xb_add(unsigned* p, unsigned v) { return __hip_atomic_fetch_add(p, v, __ATOMIC_RELAXED, __HIP_MEMORY_SCOPE_AGENT); }
__device__ __forceinline__ unsigned xb_xcc_id() { return (unsigned)__builtin_amdgcn_s_getreg((3 << 11) | 20) & 0xFu; }
#define XB_SPIN(cond, bar) do { unsigned _sp = 0; while (cond) { __builtin_amdgcn_s_sleep(1); \
    if ((++_sp & 255u) == 0u) { if (xb_ld(&(bar)[XB_TMO])) break; if (_sp > XB_SPIN_CAP) { atomicAdd(&(bar)[XB_TMO], 1u); break; } } } } while (0)
struct XcdBarrier { unsigned* bar; unsigned x; volatile LAS unsigned* st; };
__device__ __forceinline__ XcdBarrier xcd_barrier_post(unsigned* bar, volatile LAS unsigned* st) {
    XcdBarrier b; b.bar = bar; b.x = xb_xcc_id(); b.st = st;
    if (threadIdx.x == 0) (void)xb_add(&bar[XB_XCNT(b.x)], 1u);
    return b;
}
__device__ __forceinline__ void xcd_barrier_complete(unsigned* bar, unsigned x, unsigned& nloc, unsigned& nx) {
    const unsigned G = gridDim.x * gridDim.y * gridDim.z;
    unsigned sum, cnt, mine, sp = 0u;
    for (;;) {
        sum = 0u; cnt = 0u; mine = 0u;
#pragma unroll
        for (unsigned j = 0; j < 16; ++j) { const unsigned c = xb_ld(&bar[XB_XCNT(j)]); sum += c; cnt += (c > 0u) ? 1u : 0u; mine = (j == x) ? c : mine; }
        if (sum == G) break;
        __builtin_amdgcn_s_sleep(1);
        if ((++sp & 255u) == 0u) { if (xb_ld(&bar[XB_TMO])) break; if (sp > XB_SPIN_CAP) { atomicAdd(&bar[XB_TMO], 1u); break; } }
    }
    nloc = mine > 0u ? mine : 1u; nx = cnt > 0u ? cnt : 1u;
}
__device__ __forceinline__ void xcd_barrier(const XcdBarrier& b) {
    asm volatile("s_waitcnt vmcnt(0)" ::: "memory");
    __syncthreads();
    if (threadIdx.x == 0) {
        unsigned* bar = b.bar;
        __builtin_amdgcn_s_waitcnt(0);
        unsigned nloc = b.st[0], nx = b.st[1];
        if (nloc == 0u) { xcd_barrier_complete(bar, b.x, nloc, nx); b.st[0] = nloc; b.st[1] = nx; }
        const unsigned old = xb_add(&bar[XB_XSUB(b.x)], 1u);
        const unsigned gen = old / nloc;
        if (old + 1u == (gen + 1u) * nloc) {
            __builtin_amdgcn_fence(__ATOMIC_RELEASE, "agent");
            asm volatile("s_waitcnt vmcnt(0)" ::: "memory");
            const unsigned og = xb_add(&bar[XB_TOP], 1u);
            const unsigned tg = og / nx;
            if (og + 1u == (tg + 1u) * nx) xb_add(&bar[XB_TOPGEN], 1u);
            else XB_SPIN(xb_ld(&bar[XB_TOPGEN]) == tg, bar);
            __builtin_amdgcn_fence(__ATOMIC_ACQUIRE, "agent");
            xb_add(&bar[XB_XGEN(b.x)], 1u);
            asm volatile("s_waitcnt vmcnt(0)" ::: "memory");
        } else {
            XB_SPIN(xb_ld(&bar[XB_XGEN(b.x)]) == gen, bar);
            __builtin_amdgcn_fence(__ATOMIC_ACQUIRE, "agent");
            asm volatile("s_waitcnt vmcnt(0)" ::: "memory");
        }
    }
    __syncthreads();
}

namespace pg8 {
constexpr int BM = 256, BK = 64, HALF = 128, HTB = HALF * BK * 2, STAGE_BYTES = 8 * HTB, NXCD = 8, WGM = 8;
__device__ __forceinline__ int lds_byte(int r, int c) { const int st = (r >> 4) * 2 + (c >> 5), rr = r & 15, cc = c & 31, ob = rr * 64 + cc * 2; return st * 1024 + (ob ^ (((ob >> 9) & 1) << 5)); }
__device__ __forceinline__ void stage_rc(int b, int& R, int& C) { const int st = b / 1024, sb = b % 1024, swz = sb ^ (((sb >> 9) & 1) << 5); R = (st >> 1) * 16 + swz / 64; C = (st & 1) * 32 + (swz % 64) / 2; }
__device__ __forceinline__ int perm32(int rho) { const int n = rho >> 4, i = rho & 15; return 8 * (i >> 2) + 4 * n + (i & 3); }

struct Unit { int pm, pn, at, bt, e, rt; };

struct StaticOrder {
    int nM, nN, nwg, G, c;
    __device__ void init(int M, int N, int G_, int c_) { nM = M / BM; nN = N / BM; nwg = nM * nN; G = G_; c = c_; }
    __device__ bool next(int i, Unit& u) const {
        const long L = (long)i * G + c; if (L >= nwg) return false;
        int wgid = (int)L; { const int q = nwg / NXCD, r = nwg % NXCD, xcd = wgid % NXCD, off = wgid / NXCD; wgid = (xcd < r ? xcd * (q + 1) : r * (q + 1) + (xcd - r) * q) + off; }
        const int nig = WGM * nN, gid = wgid / nig, fm = gid * WGM, gsz = (nM - fm) < WGM ? (nM - fm) : WGM;
        u.pm = fm + ((wgid % nig) % gsz); u.pn = (wgid % nig) / gsz; u.at = u.pm; u.bt = u.pn; u.e = 0; u.rt = 0; return true;
    }
    __device__ __forceinline__ int token(const Unit&, int) const { return 0; }
};

struct StaticOrderOff : StaticOrder {
    int off;
    __device__ bool next(int i, Unit& u) const { if (!StaticOrder::next(i, u)) return false; u.pn += off; u.bt += off; return true; }
};

template <class Epi, class Sched, bool GATHER>
__device__ __forceinline__ void gemm_phase(LAS unsigned char* lds, const bf16_t* Ag, const bf16_t* Btg, const int K, const Sched& S, const Epi& E) {
    const int tid = threadIdx.x, wid = __builtin_amdgcn_readfirstlane(tid >> 6), lane = tid & 63, wr = wid >> 2, wc = wid & 3, fr = lane & 15, fq = lane >> 4;
    constexpr bool F8 = Epi::F8;
    const int KB = F8 ? K : 2 * K;
    const int nt = KB / (BK * 2);
    unsigned voffA[2], voffB[2];
#pragma unroll
    for (int i = 0; i < 2; ++i) { int R, C; stage_rc(tid * 16 + i * 8192, R, C); const int Rb = Epi::PERM ? ((R & ~31) + perm32(R & 31)) : R;
        voffA[i] = (unsigned)(R * KB + C * 2); voffB[i] = (unsigned)(Rb * KB + C * 2); }
    const size_t kstep = (size_t)(BK * 2);
    const size_t hstep = (size_t)HALF * KB;
    const size_t tstep = 2 * hstep;
    const unsigned ldsw = (unsigned)wid * 1024u;
    const int aoff = lds_byte(wr * 64 + fr, fq * 8), boff = lds_byte(wc * 32 + fr, fq * 8);
#define PG8_SA(b, h) (((b) * 2 + (h)) * HTB)
#define PG8_SB(b, h) ((4 + (b) * 2 + (h)) * HTB)
#define PG8_STAGE(bufoff, gbase, voff) do { _Pragma("unroll") for (int _i = 0; _i < 2; ++_i) \
        __builtin_amdgcn_global_load_lds((const unsigned*)((const char*)(gbase) + (voff)[_i]), (LAS unsigned*)(lds + (bufoff) + ldsw + _i * 8192), 16, 0, 0); } while (0)
#define PG8_STAGE_A(bufoff, NGP, GB, GO) do { if constexpr (GATHER) { PG8_STAGE(bufoff, GB, GO); } else { PG8_STAGE(bufoff, NGP, voffA); } } while (0)
#define PG8_LDA(dst, b, h) do { _Pragma("unroll") for (int m = 0; m < 4; ++m) _Pragma("unroll") for (int k = 0; k < 2; ++k) dst[m][k] = *(const LAS bf16x8*)(lds + PG8_SA(b, h) + aoff + m * 2048 + k * 1024); } while (0)
#define PG8_LDB(dst, b, h) do { _Pragma("unroll") for (int n = 0; n < 2; ++n) _Pragma("unroll") for (int k = 0; k < 2; ++k) dst[n][k] = *(const LAS bf16x8*)(lds + PG8_SB(b, h) + boff + n * 2048 + k * 1024); } while (0)
#define PG8_MMA(ai, bj, At, Bt) do { __builtin_amdgcn_s_setprio(1); _Pragma("unroll") for (int m = 0; m < 4; ++m) _Pragma("unroll") for (int n = 0; n < 2; ++n) _Pragma("unroll") for (int k = 0; k < 2; ++k) { \
        if constexpr (F8) { const i64x2 a_ = __builtin_bit_cast(i64x2, At[m][k]), b_ = __builtin_bit_cast(i64x2, Bt[n][k]);     \
            acc[ai][bj][m][n] = __builtin_amdgcn_mfma_f32_16x16x32_fp8_fp8(b_.x, a_.x, acc[ai][bj][m][n], 0, 0, 0); acc[ai][bj][m][n] = __builtin_amdgcn_mfma_f32_16x16x32_fp8_fp8(b_.y, a_.y, acc[ai][bj][m][n], 0, 0, 0); } \
        else acc[ai][bj][m][n] = __builtin_amdgcn_mfma_f32_16x16x32_bf16(Bt[n][k], At[m][k], acc[ai][bj][m][n], 0, 0, 0); } __builtin_amdgcn_s_setprio(0); } while (0)
#define PG8_WAIT_V(n) asm volatile("s_waitcnt vmcnt(" #n ")" ::: "memory")
#define PG8_WAIT_L(n) asm volatile("s_waitcnt lgkmcnt(" #n ")" ::: "memory")
#define PG8_BAR __builtin_amdgcn_s_barrier()
#define PG8_SCHED __builtin_amdgcn_sched_barrier(0)
#define PG8_GOFFS(u, o) do { _Pragma("unroll") for (int _h = 0; _h < 2; ++_h) _Pragma("unroll") for (int _i = 0; _i < 2; ++_i) { int _R, _C; stage_rc(tid * 16 + _i * 8192, _R, _C); \
        const int _tok = S.token(u, _h * HALF + _R); (o)[_h][_i] = (unsigned)(_tok * KB + _C * 2); } } while (0)
    Unit cur, nxt; int ui = 0;
    if (!S.next(0, cur)) return;
    f32x4 acc[2][2][4][2];
#pragma unroll
    for (int a = 0; a < 2; ++a)
#pragma unroll
        for (int b = 0; b < 2; ++b)
#pragma unroll
            for (int m = 0; m < 4; ++m)
#pragma unroll
                for (int n = 0; n < 2; ++n) acc[a][b][m][n] = (f32x4){0.f, 0.f, 0.f, 0.f};
    bf16x8 At[4][2], B0[2][2], B1[2][2];
    unsigned offC[2][2] = {{0u, 0u}, {0u, 0u}}, offN[2][2] = {{0u, 0u}, {0u, 0u}};
    const char* const Ab = (const char*)Ag;
    const char* cA = Ab + (size_t)cur.at * tstep; const char* cB = (const char*)Btg + (size_t)cur.bt * tstep;
    if constexpr (GATHER) { PG8_GOFFS(cur, offC); }
    PG8_STAGE(PG8_SB(0, 0), cB, voffB); PG8_STAGE(PG8_SB(0, 1), cB + hstep, voffB);
    PG8_STAGE_A(PG8_SA(0, 0), cA, Ab, offC[0]); PG8_STAGE_A(PG8_SA(0, 1), cA + hstep, Ab, offC[1]);
    if (wr == 1) PG8_BAR;
    PG8_WAIT_V(2); PG8_BAR;
    PG8_STAGE(PG8_SB(1, 0), cB + kstep, voffB); PG8_STAGE_A(PG8_SA(1, 0), cA + kstep, Ab + kstep, offC[0]); PG8_STAGE(PG8_SB(1, 1), cB + hstep + kstep, voffB);
    PG8_WAIT_V(6); PG8_BAR;
    for (;;) {
        const bool has_next = S.next(ui + 1, nxt);
        const char* nA = has_next ? Ab + (size_t)nxt.at * tstep : cA; const char* nB = has_next ? (const char*)Btg + (size_t)nxt.bt * tstep : cB;
        if constexpr (GATHER) {
            if (has_next) { PG8_GOFFS(nxt, offN); }
            else { offN[0][0] = offC[0][0]; offN[0][1] = offC[0][1]; offN[1][0] = offC[1][0]; offN[1][1] = offC[1][1]; }
        }
        for (int t = 0; t < nt; t += 2) {
            const bool last = (t == nt - 2);
            const char* a1 = cA + (size_t)(t + 1) * kstep;
            const char* a2 = last ? nA : cA + (size_t)(t + 2) * kstep; const char* b2 = last ? nB : cB + (size_t)(t + 2) * kstep;
            const char* a3 = a2 + kstep; const char* b3 = b2 + kstep;
            const char* g1 = Ab + (size_t)(t + 1) * kstep;
            const char* g2 = last ? Ab : Ab + (size_t)(t + 2) * kstep; const char* g3 = g2 + kstep;
            unsigned s0[2], s1[2];
            s0[0] = last ? offN[0][0] : offC[0][0]; s0[1] = last ? offN[0][1] : offC[0][1];
            s1[0] = last ? offN[1][0] : offC[1][0]; s1[1] = last ? offN[1][1] : offC[1][1];
            PG8_LDB(B0, 0, 0); PG8_LDB(B1, 0, 1); PG8_SCHED; PG8_LDA(At, 0, 0); PG8_STAGE_A(PG8_SA(1, 1), a1 + hstep, g1, offC[1]);
            PG8_WAIT_V(8); PG8_WAIT_L(0); PG8_BAR; PG8_MMA(0, 0, At, B0); PG8_MMA(0, 1, At, B1); PG8_BAR; PG8_SCHED;
            PG8_LDA(At, 0, 1); PG8_STAGE(PG8_SB(0, 0), b2, voffB); PG8_STAGE(PG8_SB(0, 1), b2 + hstep, voffB); PG8_STAGE_A(PG8_SA(0, 0), a2, g2, s0);
            PG8_WAIT_V(8); PG8_WAIT_L(0); PG8_BAR; PG8_MMA(1, 0, At, B0); PG8_MMA(1, 1, At, B1); PG8_BAR; PG8_SCHED;
            PG8_LDB(B0, 1, 0); PG8_LDB(B1, 1, 1); PG8_SCHED; PG8_LDA(At, 1, 0); PG8_STAGE_A(PG8_SA(0, 1), a2 + hstep, g2, s1);
            PG8_WAIT_V(8); PG8_WAIT_L(0); PG8_BAR; PG8_MMA(0, 0, At, B0); PG8_MMA(0, 1, At, B1); PG8_BAR; PG8_SCHED;
            PG8_LDA(At, 1, 1); PG8_STAGE(PG8_SB(1, 0), b3, voffB); PG8_STAGE(PG8_SB(1, 1), b3 + hstep, voffB); PG8_STAGE_A(PG8_SA(1, 0), a3, g3, s0);
            PG8_WAIT_V(8); PG8_WAIT_L(0); PG8_BAR; PG8_MMA(1, 0, At, B0); PG8_MMA(1, 1, At, B1); PG8_BAR; PG8_SCHED;
        }
        if (wr == 0) PG8_BAR;
        E(acc, cur, wr, wc, fr, fq);
        if (!has_next) break;
#pragma unroll
        for (int a = 0; a < 2; ++a)
#pragma unroll
            for (int b = 0; b < 2; ++b)
#pragma unroll
                for (int m = 0; m < 4; ++m)
#pragma unroll
                    for (int n = 0; n < 2; ++n) acc[a][b][m][n] = (f32x4){0.f, 0.f, 0.f, 0.f};
        cur = nxt; cA = nA; cB = nB; ++ui;
        if constexpr (GATHER) { offC[0][0] = offN[0][0]; offC[0][1] = offN[0][1]; offC[1][0] = offN[1][0]; offC[1][1] = offN[1][1]; }
        if (wr == 1) PG8_BAR;
    }
    PG8_WAIT_V(0);
    PG8_BAR;
#undef PG8_SA
#undef PG8_SB
#undef PG8_STAGE
#undef PG8_STAGE_A
#undef PG8_LDA
#undef PG8_LDB
#undef PG8_MMA
#undef PG8_WAIT_V
#undef PG8_WAIT_L
#undef PG8_BAR
#undef PG8_SCHED
#undef PG8_GOFFS
}
}

struct Args {
    const float* in[24];
    float* out;
    unsigned char* ws;
    int ph_lo, ph_hi;
};
enum { I_X = 0, I_NMG, I_WIN, I_CONVW, I_MU, I_W0, I_W2, I_A0, I_A2, I_G2, I_KK, I_KA, I_RK, I_LNG, I_LNB, I_WOUT, I_NFG, I_RW, I_RB, I_EW1, I_EB1, I_EW2, I_EB2, I_NFIN };
enum { PH_PREP = 0, PH_GEMM1, PH_LORA, PH_SCAN, PH_WOUT, PH_ROUTER, PH_MOE_0, PH_MOE_1, PH_MOE_2, PH_MOE_3, PH_MOE_4, PH_FINAL, NPH };

struct Ctx {
    const float* const* in; float* out; unsigned char* ws; LAS unsigned char* lds;
    int tid, lane, wave, G, bid;
};
#define WSP(T_, off) ((T_*)(C.ws + (off)))

__device__ __forceinline__ void transpose_item(const float* W, int ld, int col0, int nvalid, int k0, bf16_t* WTrow0, LAS float* scr, int lane, const float* kscale = nullptr) {
    const int c4 = 4 * (lane & 7), r0 = lane >> 3;
    f32x4 v[8];
#pragma unroll
    for (int i = 0; i < 8; ++i) v[i] = c4 < nvalid ? __builtin_nontemporal_load((const f32x4*)(W + (size_t)(k0 + r0 + 8 * i) * ld + col0 + c4)) : (f32x4){0.f, 0.f, 0.f, 0.f};
    if (kscale) {
#pragma unroll
        for (int i = 0; i < 8; ++i) v[i] *= kscale[k0 + r0 + 8 * i]; }
#pragma unroll
    for (int i = 0; i < 8; ++i) { LAS float* d = scr + (r0 + 8 * i) * 33 + c4; d[0] = v[i].x; d[1] = v[i].y; d[2] = v[i].z; d[3] = v[i].w; }
    asm volatile("s_waitcnt lgkmcnt(0)" ::: "memory");
    const int c = lane & 7;
#pragma unroll
    for (int j = 0; j < 4; ++j) { const int n = (lane >> 3) + 8 * j; const LAS float* s = scr + (8 * c) * 33 + n;
        u32x4 o; o.x = cvt_pk_bf16(s[0 * 33], s[1 * 33]); o.y = cvt_pk_bf16(s[2 * 33], s[3 * 33]); o.z = cvt_pk_bf16(s[4 * 33], s[5 * 33]); o.w = cvt_pk_bf16(s[6 * 33], s[7 * 33]);
        *(u32x4*)(WTrow0 + (size_t)n * 1024 + k0 + 8 * c) = o; }
    asm volatile("s_waitcnt lgkmcnt(0)" ::: "memory");
}
__device__ __forceinline__ void transpose_item_f8(const float* W, int ld, int col0, int k0, unsigned char* WTrow0, LAS float* scr, int lane, float scale, const float* kscale = nullptr) {
    const int c4 = 4 * (lane & 7), r0 = lane >> 3;
    f32x4 v[8];
#pragma unroll
    for (int i = 0; i < 8; ++i) v[i] = __builtin_nontemporal_load((const f32x4*)(W + (size_t)(k0 + r0 + 8 * i) * ld + col0 + c4));
#pragma unroll
    for (int i = 0; i < 8; ++i) { const float sc = kscale ? scale * kscale[k0 + r0 + 8 * i] : scale; LAS float* d = scr + (r0 + 8 * i) * 33 + c4; d[0] = v[i].x * sc; d[1] = v[i].y * sc; d[2] = v[i].z * sc; d[3] = v[i].w * sc; }
    asm volatile("s_waitcnt lgkmcnt(0)" ::: "memory");
    const int c = lane & 7;
#pragma unroll
    for (int j = 0; j < 4; ++j) { const int n = (lane >> 3) + 8 * j; const LAS float* s = scr + (8 * c) * 33 + n;
        u32x2 o; o.x = cvt4_fp8(s[0 * 33], s[1 * 33], s[2 * 33], s[3 * 33]); o.y = cvt4_fp8(s[4 * 33], s[5 * 33], s[6 * 33], s[7 * 33]);
        *(u32x2*)(WTrow0 + (size_t)n * 1024 + k0 + 8 * c) = o; }
    asm volatile("s_waitcnt lgkmcnt(0)" ::: "memory");
}
__device__ __forceinline__ void win_colmap(int np, int& col, int& nvalid) {
    const int pn = np >> 8, bj = (np >> 7) & 1, w = np & 127; nvalid = 32;
    if (pn < 8) col = (bj ? 2048 : 1024) + 128 * pn + w;
    else if (pn < 16) col = (bj ? 0 : 6432) + 128 * (pn - 8) + w;
    else if (pn < 20) col = 7456 + 256 * (pn - 16) + 128 * bj + w;
    else if (pn < 32) col = 3072 + 256 * (pn - 20) + 128 * bj + w;
    else { const int lc = 256 * (pn - 32) + 128 * bj + w; col = 6144 + lc; nvalid = 288 - lc; nvalid = nvalid < 0 ? 0 : (nvalid > 32 ? 32 : nvalid); if (nvalid == 0) col = 0; }
}
__device__ __forceinline__ void rms_row_to_bf16(const float* xrow, const float* g, bf16_t* orow, int lane) {
    const f32x4* xr = (const f32x4*)xrow + lane;
    f32x4 v[4]; float s = 0.f;
#pragma unroll
    for (int j = 0; j < 4; ++j) { v[j] = xr[64 * j]; s += (v[j].x * v[j].x + v[j].y * v[j].y) + (v[j].z * v[j].z + v[j].w * v[j].w); }
    const float rstd = rsqrtf(wave_sum(s) * (1.f / D) + 1e-5f);
    u32x2* o8 = (u32x2*)orow + lane;
#pragma unroll
    for (int j = 0; j < 4; ++j) { const f32x4 gv = ((const f32x4*)g)[lane + 64 * j]; u32x2 o; o.x = cvt_pk_bf16(v[j].x * rstd * gv.x, v[j].y * rstd * gv.y); o.y = cvt_pk_bf16(v[j].z * rstd * gv.z, v[j].w * rstd * gv.w); o8[64 * j] = o; }
}
__device__ __forceinline__ void phase_prep(const Ctx& C) {
    LAS float* scr = (LAS float*)(C.lds + C.wave * 16384);
    const int gw = C.bid * 8 + C.wave, NGW = C.G * 8;
    if (C.bid == 0 && C.tid < 128) WSP(unsigned, WS_CNT)[C.tid] = 0u;
    constexpr int I_IN = (N1 / 32) * 16, I_OUT = (D / 32) * 16;
    for (int it = gw; it < I_IN + I_OUT; it += NGW) {
        if (it < I_IN) { const int nb = it >> 4, kb = it & 15; int col, nv; win_colmap(nb * 32, col, nv);
            if (nb * 32 >= F8LO * 256 && nb * 32 < NF8 * 256) transpose_item_f8(C.in[I_WIN], PROJ, col, kb * 64, (unsigned char*)C.out + DO_WIN8 + (size_t)nb * 32 * 1024, scr, C.lane, 64.0f);
            else transpose_item(C.in[I_WIN], PROJ, col, nv, kb * 64, WSP(bf16_t, WS_WINT) + (size_t)nb * 32 * 1024, scr, C.lane); }
        else { const int r = it - I_IN, nb = r >> 4, kb = r & 15;
            transpose_item(C.in[I_WOUT], D, nb * 32, 32, kb * 64, WSP(bf16_t, WS_WOUTT) + (size_t)nb * 32 * 1024, scr, C.lane); }
    }
    for (int m = gw; m < T; m += 2 * NGW) {
        const int m2 = m + NGW < T ? m + NGW : m;
        const f32x4* xa = (const f32x4*)(C.in[I_X] + (size_t)m * D) + C.lane; const f32x4* xb = (const f32x4*)(C.in[I_X] + (size_t)m2 * D) + C.lane;
        f32x4 va[4], vb[4]; float sa = 0.f, sb = 0.f;
#pragma unroll
        for (int j = 0; j < 4; ++j) { va[j] = __builtin_nontemporal_load(xa + 64 * j); vb[j] = __builtin_nontemporal_load(xb + 64 * j); }
#pragma unroll
        for (int j = 0; j < 4; ++j) { sa += (va[j].x * va[j].x + va[j].y * va[j].y) + (va[j].z * va[j].z + va[j].w * va[j].w); sb += (vb[j].x * vb[j].x + vb[j].y * vb[j].y) + (vb[j].z * vb[j].z + vb[j].w * vb[j].w); }
#pragma unroll
        for (int o = 1; o < 64; o <<= 1) { sa += __shfl_xor(sa, o); sb += __shfl_xor(sb, o); }
        const float ra = rsqrtf(sa * (1.f / D) + 1e-5f), rb = rsqrtf(sb * (1.f / D) + 1e-5f);
        u32x2* oa = (u32x2*)(WSP(bf16_t, WS_R0) + (size_t)m * D) + C.lane; u32x2* ob = (u32x2*)(WSP(bf16_t, WS_R0) + (size_t)m2 * D) + C.lane;
        unsigned* qa = (unsigned*)((unsigned char*)C.out + DO_XN8 + (size_t)m * D) + C.lane; unsigned* qb = (unsigned*)((unsigned char*)C.out + DO_XN8 + (size_t)m2 * D) + C.lane;
#pragma unroll
        for (int j = 0; j < 4; ++j) { const f32x4 gv = ((const f32x4*)C.in[I_NMG])[C.lane + 64 * j]; u32x2 o;
            o.x = cvt_pk_bf16(va[j].x * ra * gv.x, va[j].y * ra * gv.y); o.y = cvt_pk_bf16(va[j].z * ra * gv.z, va[j].w * ra * gv.w); oa[64 * j] = o;
            qa[64 * j] = cvt4_fp8(va[j].x * ra * gv.x, va[j].y * ra * gv.y, va[j].z * ra * gv.z, va[j].w * ra * gv.w);
            o.x = cvt_pk_bf16(vb[j].x * rb * gv.x, vb[j].y * rb * gv.y); o.y = cvt_pk_bf16(vb[j].z * rb * gv.z, vb[j].w * rb * gv.w); ob[64 * j] = o;
            qb[64 * j] = cvt4_fp8(vb[j].x * rb * gv.x, vb[j].y * rb * gv.y, vb[j].z * rb * gv.z, vb[j].w * rb * gv.w); }
    }
    for (int i = C.bid * 512 + C.tid; i < D * 64; i += C.G * 512) { const int c = i >> 6, k = i & 63;
        WSP(bf16_t, WS_W2T)[i] = (bf16_t)(cvt_pk_bf16(C.in[I_W2][(size_t)k * D + c], 0.f) & 0xffffu); WSP(bf16_t, WS_A2T)[i] = (bf16_t)(cvt_pk_bf16(C.in[I_A2][(size_t)k * D + c], 0.f) & 0xffffu); }
    for (int i = C.bid * 512 + C.tid; i < D * 160; i += C.G * 512) { const int c = i / 160, k = i - c * 160;
        WSP(bf16_t, WS_G2T)[i] = (bf16_t)(cvt_pk_bf16(C.in[I_G2][(size_t)k * D + c], 0.f) & 0xffffu); }
    for (int i = C.bid * 512 + C.tid; i < D * NE; i += C.G * 512) { const int c = i >> 5, e = i & 31; const float v = C.in[I_NFG][c] * C.in[I_RW][i];
        const unsigned hi = cvt_pk_bf16(v, 0.f) & 0xffffu; const float r = v - __uint_as_float(hi << 16); const unsigned lo = cvt_pk_bf16(r, 0.f) & 0xffffu;
        const int o = ((c >> 4) * 32 + e) * 16 + (c & 15); WSP(bf16_t, WS_RWG)[o] = (bf16_t)hi; WSP(bf16_t, WS_RWG)[32768 + o] = (bf16_t)lo; }
}
__device__ __forceinline__ void phase_cvt_experts(const Ctx& C) {
    LAS float* scr = (LAS float*)(C.lds + C.wave * 16384);
    const int gw = C.bid * 8 + C.wave, NGW = C.G * 8;
    constexpr int I_1 = NE * (2048 / 32) * 16, I_2 = NE * (1024 / 32) * 16;
    for (int it = gw; it < I_1 + I_2; it += NGW) {
        if (it < I_1) { const int e = it / (64 * 16), r = it % (64 * 16), nb = r >> 4, kb = r & 15; const int np = nb * 32, pn = np >> 8, bj = (np >> 7) & 1, w = np & 127;
            const int col = (bj ? 1024 : 0) + 128 * pn + w;
            transpose_item_f8(C.in[I_EW1] + (size_t)e * 1024 * 2048, 2048, col, kb * 64, WSP(unsigned char, WS_R0) + ((size_t)e * 2048 + np) * 1024, scr, C.lane, 64.0f, C.in[I_NFG]); }
        else { const int q = it - I_1, e = q / (32 * 16), r = q % (32 * 16), nb = r >> 4, kb = r & 15;
            transpose_item_f8(C.in[I_EW2] + (size_t)e * 1024 * 1024, 1024, nb * 32, kb * 64, (unsigned char*)C.out + DO_W2T + ((size_t)e * 1024 + nb * 32) * 1024, scr, C.lane, 64.0f); }
    }
}

template <bool F8_> struct EpiP1T {
    static constexpr bool PERM = true, F8 = F8_; static constexpr float SC = F8_ ? 0.015625f : 1.0f;
    unsigned char* ws;
    __device__ __forceinline__ void operator()(const f32x4 (&acc)[2][2][4][2], const pg8::Unit& u, int wr, int wc, int fr, int fq) const {
        const int pn = u.pn, row0 = u.pm * 256 + wr * 64 + fr, cl = wc * 32 + 8 * fq;
        if (pn < 16) {
            bf16_t* O = (bf16_t*)(ws + WS_R1 + (size_t)(pn >> 3) * (128 * MiB)) + 128 * (pn & 7) + cl;
#pragma unroll
            for (int ai = 0; ai < 2; ++ai)
#pragma unroll
                for (int m = 0; m < 4; ++m) {
                    f32x4 a0 = acc[ai][0][m][0] * SC, a1 = acc[ai][0][m][1] * SC; const f32x4 b0 = acc[ai][1][m][0] * SC, b1 = acc[ai][1][m][1] * SC;
                    if (pn >= 8) {
#pragma unroll
                        for (int j = 0; j < 4; ++j) { a0[j] = sigmoidf_(a0[j]); a1[j] = sigmoidf_(a1[j]); }
                    }
                    a0 = a0 * b0; a1 = a1 * b1;
                    u32x4 w; w.x = cvt_pk_bf16(a0[0], a0[1]); w.y = cvt_pk_bf16(a0[2], a0[3]); w.z = cvt_pk_bf16(a1[0], a1[1]); w.w = cvt_pk_bf16(a1[2], a1[3]);
                    __builtin_nontemporal_store(w, (u32x4*)(O + (size_t)(row0 + ai * 128 + m * 16) * D));
                }
        } else {
            int rix, c0, ld = D; const bool sg = pn < 20;
            if (pn < 20) { rix = 3; c0 = 256 * (pn - 16); }
            else if (pn < 32) { const int q = pn - 20; rix = 4 + (q >> 2); c0 = 256 * (q & 3); }
            else { rix = 7; c0 = 256 * (pn - 32); ld = LORA_LD; }
            bf16_t* O = (bf16_t*)(ws + WS_R0 + (size_t)rix * (128 * MiB)) + c0 + cl;
#pragma unroll
            for (int ai = 0; ai < 2; ++ai)
#pragma unroll
                for (int m = 0; m < 4; ++m)
#pragma unroll
                    for (int bj = 0; bj < 2; ++bj) {
                        f32x4 a0 = acc[ai][bj][m][0] * SC, a1 = acc[ai][bj][m][1] * SC;
                        if (sg) {
#pragma unroll
                            for (int j = 0; j < 4; ++j) { a0[j] = sigmoidf_(a0[j]); a1[j] = sigmoidf_(a1[j]); }
                        }
                        u32x4 w; w.x = cvt_pk_bf16(a0[0], a0[1]); w.y = cvt_pk_bf16(a0[2], a0[3]); w.z = cvt_pk_bf16(a1[0], a1[1]); w.w = cvt_pk_bf16(a1[2], a1[3]);
                        __builtin_nontemporal_store(w, (u32x4*)(O + (size_t)(row0 + ai * 128 + m * 16) * ld + bj * 128));
                    }
        }
    }
};

__device__ __forceinline__ void phase_lact(const Ctx& C) {
    const bf16_t* LORA = WSP(bf16_t, WS_R7); bf16_t* LACT = (bf16_t*)((unsigned char*)C.out + DO_LACT); const float* mu = C.in[I_MU] + 3072;
    constexpr int NI = T * 40, UN = 4; const int S = C.G * 512;
    for (int item0 = C.bid * 512 + C.tid; item0 < NI; item0 += UN * S) {
        u32x4 rc[UN], rp[UN];
#pragma unroll
        for (int q = 0; q < UN; ++q) { const int item = item0 + q * S; rc[q] = (u32x4){0u, 0u, 0u, 0u}; rp[q] = rc[q];
            if (item < NI) { const int t = item / 40, c = (item - t * 40) * 8;
                if (c < 288) { rc[q] = *(const u32x4*)(LORA + (size_t)t * LORA_LD + c); if (t & (SEQ - 1)) rp[q] = *(const u32x4*)(LORA + (size_t)(t - 1) * LORA_LD + c); } } }
#pragma unroll
        for (int q = 0; q < UN; ++q) { const int item = item0 + q * S;
            if (item < NI) { const int t = item / 40, c = (item - t * 40) * 8;
                u32x4 o = {0u, 0u, 0u, 0u};
                if (c < 288) {
                    float cur[8], prev[8], v[8];
                    unpack8(rc[q], cur); unpack8(rp[q], prev);
                    const f32x4 m0 = *(const f32x4*)(mu + c), m1 = *(const f32x4*)(mu + c + 4);
#pragma unroll
                    for (int j = 0; j < 8; ++j) { const float m = j < 4 ? m0[j] : m1[j - 4]; float x = cur[j] + (prev[j] - cur[j]) * m;
                        if (c < 64) x = 1.0f - 2.0f * fast_rcp(1.0f + __expf(2.0f * x));
                        else if (c >= 128) x = sigmoidf_(x);
                        v[j] = x; }
                    o.x = cvt_pk_bf16(v[0], v[1]); o.y = cvt_pk_bf16(v[2], v[3]); o.z = cvt_pk_bf16(v[4], v[5]); o.w = cvt_pk_bf16(v[6], v[7]);
                }
                *(u32x4*)(LACT + (size_t)t * LACT_LD + c) = o; } }
    }
}

namespace mx {
constexpr int SLOT = 9216, ROWB = 144;
constexpr int F32ROWB = 272;
constexpr int G2T_RB = 336, LACT_OFF = 6 * SLOT, LACT_RB = 656;
constexpr int HBS = 12;
constexpr int SM_BON = 13 * SLOT, SM_GC = SM_BON + 256, SM_CST = SM_GC + 256;
constexpr int PW2T_OFF = SM_CST + 12 * 256, PA2T_OFF = PW2T_OFF + SLOT, PG2T_OFF = PA2T_OFF + SLOT;
static_assert(LACT_OFF + 64 * LACT_RB <= 11 * SLOT, "staging area");
constexpr int SM_C1 = PG2T_OFF + 64 * G2T_RB, SM_CNV = SM_C1 + 256;
static_assert(SM_CNV + 16 <= MISC_OFF, "mixer LDS map");
struct SrcLds { LAS const unsigned char* base; __device__ __forceinline__ bf16x8 operator()(int row, int s, int hh) const { return *(const LAS bf16x8*)(base + row * ROWB + (16 * s + 8 * hh) * 2); } };
template <int RB> struct SrcLdsR { LAS const unsigned char* base; __device__ __forceinline__ bf16x8 operator()(int row, int s, int hh) const { return *(const LAS bf16x8*)(base + row * RB + (16 * s + 8 * hh) * 2); } };
typedef short s16x4 __attribute__((ext_vector_type(4)));
struct SrcLdsT { LAS const unsigned char* base; __device__ __forceinline__ bf16x8 operator()(int, int s, int) const {
        const s16x4 lo = __builtin_amdgcn_ds_read_tr16_b64_v4i16((LAS s16x4*)(base + s * (16 * ROWB))), hi = __builtin_amdgcn_ds_read_tr16_b64_v4i16((LAS s16x4*)(base + s * (16 * ROWB) + 4 * ROWB));
        return __builtin_shufflevector(lo, hi, 0, 1, 2, 3, 4, 5, 6, 7); } };
struct SrcRegs { bf16x8 f[4]; __device__ __forceinline__ bf16x8 operator()(int, int s, int) const { return f[s]; } };
__device__ __forceinline__ SrcRegs preload(LAS const unsigned char* base, int row, int hh) { SrcRegs r;
#pragma unroll
    for (int s = 0; s < 4; ++s) r.f[s] = *(const LAS bf16x8*)(base + row * ROWB + (16 * s + 8 * hh) * 2);
    return r; }
template <bool TRI> struct SrcGen {
    __device__ __forceinline__ bf16x8 operator()(int row, int s, int hh) const { const int k0 = 16 * s + 8 * hh; unsigned w[4];
#pragma unroll
        for (int j = 0; j < 4; ++j) { const int ka = k0 + 2 * j, kb = ka + 1; const bool a = TRI ? (ka <= row) : (ka == row), b = TRI ? (kb <= row) : (kb == row); w[j] = (a ? 0x3F80u : 0u) | (b ? 0x3F800000u : 0u); }
        const u32x4 v = {w[0], w[1], w[2], w[3]}; return __builtin_bit_cast(bf16x8, v); } };
template <int KS, class PS, class QS>
__device__ __forceinline__ f32x16 mm(f32x16 acc, const PS& P, const QS& Q, int prow, int qrow, int hh) {
#pragma unroll
    for (int s = 0; s < KS; ++s) { const bf16x8 a = Q(qrow, s, hh), b = P(prow, s, hh); acc = __builtin_amdgcn_mfma_f32_32x32x16_bf16(a, b, acc, 0, 0, 0); }
    return acc;
}
__device__ __forceinline__ f32x16 zero16() { f32x16 z;
#pragma unroll
    for (int q = 0; q < 16; ++q) z[q] = 0.f;
    return z; }
__device__ __forceinline__ f32x4 quad(const f32x16& a, int q4) { return (f32x4){a[4 * q4], a[4 * q4 + 1], a[4 * q4 + 2], a[4 * q4 + 3]}; }
__device__ __forceinline__ void st_bf4(LAS unsigned char* slot, int p, int q0, f32x4 v) { u32x2 w; w.x = cvt_pk_bf16(v.x, v.y); w.y = cvt_pk_bf16(v.z, v.w); *(LAS u32x2*)(slot + p * ROWB + q0 * 2) = w; }
__device__ __forceinline__ f32x4 ld_bf4(LAS const unsigned char* slot, int p, int q0) { const u32x2 w = *(const LAS u32x2*)(slot + p * ROWB + q0 * 2); return (f32x4){bf_lo(w.x), bf_hi(w.x), bf_lo(w.y), bf_hi(w.y)}; }
template <int MODE> __device__ __forceinline__ f32x4 mask4(f32x4 v, int p, int q0) {
    if (MODE == 0) return v;
#pragma unroll
    for (int e = 0; e < 4; ++e) { const int q = q0 + e; const bool keep = MODE == 1 ? (q < p) : (MODE == 2 ? (q <= p) : (q > p)); v[e] = keep ? v[e] : 0.f; }
    return v;
}
__device__ __forceinline__ void unpack4p(const u32x4 w, f32x2 (&p)[4]) { p[0] = (f32x2){bf_lo(w.x), bf_hi(w.x)}; p[1] = (f32x2){bf_lo(w.y), bf_hi(w.y)}; p[2] = (f32x2){bf_lo(w.z), bf_hi(w.z)}; p[3] = (f32x2){bf_lo(w.w), bf_hi(w.w)}; }
__device__ __forceinline__ unsigned cvt_pk2(f32x2 v) { const bf16x2_t r = __builtin_convertvector(v, bf16x2_t); return __builtin_bit_cast(unsigned, r); }
__device__ __forceinline__ f32x2 exp2p(f32x2 v) { return (f32x2){__builtin_amdgcn_exp2f(v.x), __builtin_amdgcn_exp2f(v.y)}; }
__device__ __forceinline__ f32x2 rcpp(f32x2 v) { return (f32x2){fast_rcp(v.x), fast_rcp(v.y)}; }
__device__ __forceinline__ f32x2 splat2(float x) { return (f32x2){x, x}; }
}

__device__ __forceinline__ void phase_mixer(const Ctx& C) {
    using namespace mx;
    const int tid = C.tid, lane = C.lane, grp = C.wave >> 2, w4 = C.wave & 3, wp = w4 >> 1, wq = w4 & 1, r = lane & 31, hh = lane >> 5;
    int prow = 32 * wp + r, qrow = 32 * wq + r;
    int te = tid >> 3, jo = tid & 7;
    const int trl = (8 * hh + ((lane & 15) >> 2)) * ROWB + 8 * (lane & 3); int trP = trl + 2 * (prow & ~15), trQ = trl + 2 * (qrow & ~15);
    LAS unsigned char* const L = C.lds;
#define SL(k) (L + (k) * SLOT)
#define MX_BAR() do { asm volatile("s_waitcnt lgkmcnt(0)\n\ts_barrier" ::: "memory"); } while (0)
#define MX_OPAQUE() do { asm volatile("" : "+v"(prow), "+v"(qrow), "+v"(trP), "+v"(trQ), "+v"(te), "+v"(jo)); } while (0)
#define MM_STORE_G() do { const f32x16 acc_ = mm<10>(zero16(), ACTG, G2T, prow, qrow, hh); _Pragma("unroll") for (int q4 = 0; q4 < 4; ++q4) st_bf4(SL(5), prow, 32 * wq + 8 * q4 + 4 * hh, quad(acc_, q4)); } while (0)
    LAS float* const BON = (LAS float*)(L + SM_BON); LAS float* const GCV = (LAS float*)(L + SM_GC); LAS unsigned* const CNV = (LAS unsigned*)(L + SM_CNV);
    const bf16_t* Rg = WSP(bf16_t, WS_R4); const bf16_t* Kg = WSP(bf16_t, WS_R5); const bf16_t* Vg = WSP(bf16_t, WS_R6);
    const bf16_t* LACT = (const bf16_t*)((const unsigned char*)C.out + DO_LACT); bf16_t* Yg = (bf16_t*)C.out;
    const bf16_t* Ug = WSP(bf16_t, WS_R1); const bf16_t* GBg = WSP(bf16_t, WS_R2); const bf16_t* GRg = WSP(bf16_t, WS_R3);
    const SrcGen<true> TRI{};
    for (int pair = C.bid; pair < NB * NH; pair += C.G) {
        const int b = pair >> 4, h = pair & 15, cbase = h * HD;
        const bf16_t* const gW2T = WSP(bf16_t, WS_W2T) + (size_t)cbase * 64; const bf16_t* const gA2T = WSP(bf16_t, WS_A2T) + (size_t)cbase * 64; const bf16_t* const gG2T = WSP(bf16_t, WS_G2T) + (size_t)cbase * 160;
        const SrcLdsR<ROWB> W2T{L + PW2T_OFF}, A2T{L + PA2T_OFF}; const SrcLdsR<G2T_RB> G2T{L + PG2T_OFF};
        const SrcLdsR<LACT_RB> ACTW{L + LACT_OFF}, ACTA{L + LACT_OFF + 128}, ACTG{L + LACT_OFF + 256};
        f32x16 Keep = zero16();
        { LAS float* cst = (LAS float*)(L + SM_CST); const int a = tid >> 6, j = tid & 63;
          const float* src = a == 0 ? C.in[I_MU] : a == 1 ? C.in[I_MU] + 1024 : a == 2 ? C.in[I_MU] + 2048 : a == 3 ? C.in[I_KK] : a == 4 ? C.in[I_KA] : a == 5 ? C.in[I_RK] : a == 6 ? C.in[I_LNG] : C.in[I_LNB];
          cst[tid] = src[cbase + j];
          if (tid < 128) cst[512 + tid] = -1.44269504f * (tid < 64 ? C.in[I_W0][cbase + tid] : C.in[I_A0][cbase + tid - 64]);
          else if (tid < 320) { const int tp = (tid - 128) >> 6; const float cw = C.in[I_CONVW][tp * D + cbase + j];
              if (tp == 1) ((LAS float*)(L + SM_C1))[j] = cw; else cst[(tp == 0 ? 640 : 704) + j] = cw; } }
        for (int i = tid; i < SLOT / 16; i += 512) ((LAS u32x4*)SL(HBS))[i] = (u32x4){0u, 0u, 0u, 0u};
        { const bf16_t* gr_ = gG2T + (size_t)te * 160 + jo * 8; LAS unsigned char* lr_ = L + PG2T_OFF + te * G2T_RB + jo * 16;
          const u32x4 w0_ = *(const u32x4*)(gW2T + (size_t)te * 64 + jo * 8), w1_ = *(const u32x4*)(gA2T + (size_t)te * 64 + jo * 8), g0_ = *(const u32x4*)gr_, g1_ = *(const u32x4*)(gr_ + 64);
          *(LAS u32x4*)(L + PW2T_OFF + te * ROWB + jo * 16) = w0_; *(LAS u32x4*)(L + PA2T_OFF + te * ROWB + jo * 16) = w1_; *(LAS u32x4*)lr_ = g0_; *(LAS u32x4*)(lr_ + 128) = g1_;
          if (jo < 4) { const u32x4 g2_ = *(const u32x4*)(gr_ + 128); *(LAS u32x4*)(lr_ + 256) = g2_; }
          asm volatile("" ::: "memory"); }
        u32x4 pf[5];
#define PF_LOAD(tok0_) do { const bf16_t* pg_ = LACT + (size_t)((tok0_) + te) * LACT_LD + jo * 8; _Pragma("unroll") for (int k = 0; k < 5; ++k) pf[k] = __builtin_nontemporal_load((const u32x4*)(pg_ + 64 * k)); } while (0)
        PF_LOAD(b * SEQ);
#define PF_STORE() do { _Pragma("unroll") for (int k = 0; k < 5; ++k) *(LAS u32x4*)(L + LACT_OFF + te * LACT_RB + jo * 16 + 128 * k) = pf[k]; asm volatile("" ::: "memory"); } while (0)
        PF_STORE();
        size_t ga = (size_t)(b * SEQ + te) * D + cbase + 8 * jo;
        u32x4 rR = *(const u32x4*)(Rg + ga), rK = *(const u32x4*)(Kg + ga), rV = *(const u32x4*)(Vg + ga);
        u32x4 rRp = {0u, 0u, 0u, 0u}, rKp = rRp, rVp = rRp;
        if (te > 0) { rRp = *(const u32x4*)(Rg + ga - D); rKp = *(const u32x4*)(Kg + ga - D); rVp = *(const u32x4*)(Vg + ga - D); }
        MX_BAR();
        for (int ch = 0; ch < SEQ / 64; ++ch) {
            MX_OPAQUE();
            const int tok0 = b * SEQ + ch * 64;
            if (grp == 0) { const f32x16 acc = mm<4>(zero16(), ACTA, A2T, prow, qrow, hh);
#pragma unroll
                for (int q4 = 0; q4 < 4; ++q4) { const int q0 = 32 * wq + 8 * q4 + 4 * hh; f32x4 v = quad(acc, q4); const f32x4 a0 = *(const LAS f32x4*)(L + SM_CST + (9 * 64 + q0) * 4);
#pragma unroll
                    for (int e = 0; e < 4; ++e) v[e] = fast_rcp(1.0f + __builtin_amdgcn_exp2f(__builtin_fmaf(v[e], -1.44269504f, a0[e])));
                    st_bf4(SL(4), prow, q0, v); } }
            else { const f32x16 acc = mm<4>(zero16(), ACTW, W2T, prow, qrow, hh);
#pragma unroll
                for (int q4 = 0; q4 < 4; ++q4) { const int q0 = 32 * wq + 8 * q4 + 4 * hh; f32x4 v = quad(acc, q4); const f32x4 w0 = *(const LAS f32x4*)(L + SM_CST + (8 * 64 + q0) * 4);
#pragma unroll
                    for (int e = 0; e < 4; ++e) v[e] = fast_rcp(__builtin_fmaf(__builtin_amdgcn_exp2f(__builtin_fmaf(v[e], -1.44269504f, w0[e])), -1.64872127f, -1.64872127f));
                    st_bf4(SL(1), prow, q0, v); } }
            MX_BAR();
            if (grp == 0) { int pz = prow; asm volatile("" : "+v"(pz)); const f32x16 acc = mm<4>(zero16(), TRI, SrcLdsT{SL(1) + trQ}, pz, qrow, hh);
#pragma unroll
                for (int q4 = 0; q4 < 4; ++q4) *(LAS f32x4*)(SL(2) + prow * F32ROWB + (32 * wq + 8 * q4 + 4 * hh) * 4) = quad(acc, q4); }
            else MM_STORE_G();
            MX_BAR();
            f32x2 vs[4];
            const u32x4 gpk = *(const LAS u32x4*)(SL(5) + te * ROWB + jo * 16);
            {
                const LAS float* cst = (const LAS float*)(L + SM_CST) + 8 * jo;
#define CSTP(a_, dst) do { const f32x4 x0_ = *(const LAS f32x4*)(cst + 64 * (a_)), x1_ = *(const LAS f32x4*)(cst + 64 * (a_) + 4); dst[0] = (f32x2){x0_.x, x0_.y}; dst[1] = (f32x2){x0_.z, x0_.w}; dst[2] = (f32x2){x1_.x, x1_.y}; dst[3] = (f32x2){x1_.z, x1_.w}; } while (0)
#define STP(slot, o) do { u32x4 w_; w_.x = cvt_pk2(o[0]); w_.y = cvt_pk2(o[1]); w_.z = cvt_pk2(o[2]); w_.w = cvt_pk2(o[3]); *(LAS u32x4*)(SL(slot) + te * ROWB + jo * 16) = w_; } while (0)
                f32x2 rr[4], kx[4], tmp[4], cc[4];
                unpack4p(rV, vs); unpack4p(rVp, tmp); CSTP(2, cc);
#pragma unroll
                for (int i = 0; i < 4; ++i) vs[i] = vs[i] + (tmp[i] - vs[i]) * cc[i];
                STP(11, vs);
                unpack4p(rR, rr); unpack4p(rRp, tmp); CSTP(0, cc);
#pragma unroll
                for (int i = 0; i < 4; ++i) rr[i] = rr[i] + (tmp[i] - rr[i]) * cc[i];
                unpack4p(rK, kx); unpack4p(rKp, tmp); CSTP(1, cc);
#pragma unroll
                for (int i = 0; i < 4; ++i) kx[i] = kx[i] + (tmp[i] - kx[i]) * cc[i];
                f32x2 kk[4], av[4]; f32x2 ss2 = splat2(0.f), bn2 = splat2(0.f);
                CSTP(3, cc);
#pragma unroll
                for (int i = 0; i < 4; ++i) { kk[i] = kx[i] * cc[i]; ss2 = ss2 + kk[i] * kk[i]; }
                unpack4p(*(const LAS u32x4*)(SL(4) + te * ROWB + jo * 16), av); CSTP(4, cc);
#pragma unroll
                for (int i = 0; i < 4; ++i) kx[i] = kx[i] * (splat2(1.0f) + (av[i] - splat2(1.0f)) * cc[i]);
                CSTP(5, cc);
#pragma unroll
                for (int i = 0; i < 4; ++i) bn2 = bn2 + rr[i] * kx[i] * cc[i];
                const float ss = sum8(ss2.x + ss2.y), bn = sum8(bn2.x + bn2.y);
                const f32x2 inv = splat2(fminf(__builtin_amdgcn_rsqf(ss), 1e12f));
                if (jo == 0) BON[te] = bn;
                if (tid == 0) *(LAS u32x4*)CNV = (u32x4){0u, 0u, 0u, 0u};
                f32x2 cm[4], ex[4]; const f32x2 L2E = splat2(1.44269504f);
                { const f32x4 c0 = *(const LAS f32x4*)(SL(2) + te * F32ROWB + jo * 32), c1 = *(const LAS f32x4*)(SL(2) + te * F32ROWB + jo * 32 + 16);
                  cm[0] = (f32x2){c0.x, c0.y}; cm[1] = (f32x2){c0.z, c0.w}; cm[2] = (f32x2){c1.x, c1.y}; cm[3] = (f32x2){c1.z, c1.w}; }
                unpack4p(*(const LAS u32x4*)(SL(1) + te * ROWB + jo * 16), tmp);
#pragma unroll
                for (int i = 0; i < 4; ++i) { kk[i] = kk[i] * inv; ex[i] = kk[i] * exp2p((cm[i] - tmp[i]) * L2E); }
                STP(5, ex);
#pragma unroll
                for (int i = 0; i < 4; ++i) { kk[i] = kk[i] * av[i]; cm[i] = exp2p(cm[i] * L2E); ex[i] = rr[i] * cm[i]; }
                STP(8, ex);
                if (te == 63) { *(LAS f32x4*)(GCV + 8 * jo) = (f32x4){cm[0].x, cm[0].y, cm[1].x, cm[1].y}; *(LAS f32x4*)(GCV + 8 * jo + 4) = (f32x4){cm[2].x, cm[2].y, cm[3].x, cm[3].y}; }
#pragma unroll
                for (int i = 0; i < 4; ++i) { const f32x2 ri = rcpp(cm[i]); ex[i] = kx[i] * ri; kk[i] = kk[i] * ri; }
                STP(6, ex);
                STP(7, kk);
            }
            MX_BAR();
#define MM_STORE(dst, PS_, QS_) do { const f32x16 acc_ = mm<4>(zero16(), PS_, QS_, prow, qrow, hh); _Pragma("unroll") for (int q4 = 0; q4 < 4; ++q4) st_bf4(SL(dst), prow, 32 * wq + 8 * q4 + 4 * hh, quad(acc_, q4)); } while (0)
#define MM_STORE_MASK(dst, MODE_, PS_, QS_) do { const f32x16 acc_ = mm<4>(zero16(), PS_, QS_, prow, qrow, hh); _Pragma("unroll") for (int q4 = 0; q4 < 4; ++q4) { const int q0_ = 32 * wq + 8 * q4 + 4 * hh; st_bf4(SL(dst), prow, q0_, mask4<MODE_>(quad(acc_, q4), prow, q0_)); } } while (0)
            f32x16 z0;
            const u32x4 mU0 = *(const u32x4*)(Ug + ga), mGB = __builtin_nontemporal_load((const u32x4*)(GBg + ga)), mGR = __builtin_nontemporal_load((const u32x4*)(GRg + ga));
            u32x4 mU1 = {0u, 0u, 0u, 0u}, mU2 = mU1;
            if (ch > 0 || te >= 1) mU1 = *(const u32x4*)(Ug + ga - D);
            if (ch > 0 || te >= 2) mU2 = *(const u32x4*)(Ug + ga - 2 * D);
            if (grp == 0) { const SrcRegs KKp = preload(SL(5), prow, hh), Bq = preload(SL(7), qrow, hh);
                MM_STORE_MASK(0, 1, KKp, SrcLds{SL(6)});
                MM_STORE_MASK(1, 1, KKp, Bq);
                MM_STORE_MASK(4, 2, SrcLds{SL(8)}, Bq);
            } else { const SrcRegs Rp = preload(SL(8), prow, hh);
                MM_STORE_MASK(3, 2, Rp, SrcLds{SL(6)});
                z0 = mm<4>(zero16(), SrcLds{SL(HBS)}, SrcLds{SL(5)}, prow, qrow, hh);
                Keep = mm<4>(zero16(), Rp, SrcLds{SL(HBS)}, prow, qrow, hh);
            }
            MX_BAR();
            if (grp == 0) MM_STORE(9, SrcLds{SL(1)}, SrcLdsT{SL(1) + trQ});
            else { z0 = mm<4>(z0, SrcLdsT{SL(11) + trP}, SrcLds{SL(0)}, prow, qrow, hh);
#pragma unroll
                for (int q4 = 0; q4 < 4; ++q4) st_bf4(SL(10), prow, 32 * wq + 8 * q4 + 4 * hh, quad(z0, q4)); }
            MX_BAR();
            PF_LOAD(tok0 + (ch + 1 < SEQ / 64 ? 64 : 0));
            if (grp == 0) { const f32x16 acc = mm<4>(zero16(), SrcLds{SL(1)}, SrcLdsT{SL(9) + trQ}, prow, qrow, hh);
#pragma unroll
                for (int q4 = 0; q4 < 4; ++q4) { const int q0 = 32 * wq + 8 * q4 + 4 * hh; f32x4 v = ld_bf4(SL(9), prow, q0) - ld_bf4(SL(1), prow, q0) - quad(acc, q4);
#pragma unroll
                    for (int e = 0; e < 4; ++e) v[e] += (q0 + e == prow) ? 1.0f : 0.0f;
                    st_bf4(SL(8), prow, q0, v); } }
            else MM_STORE(5, SrcLds{SL(9)}, SrcLdsT{SL(9) + trQ});
            MX_BAR();
#define T_UPDATE(dst, tsrc, msrc) do { const f32x16 acc_ = mm<4>(zero16(), SrcLds{SL(tsrc)}, SrcLdsT{SL(msrc) + trQ}, prow, qrow, hh); _Pragma("unroll") for (int q4 = 0; q4 < 4; ++q4) { const int q0_ = 32 * wq + 8 * q4 + 4 * hh; st_bf4(SL(dst), prow, q0_, ld_bf4(SL(tsrc), prow, q0_) + quad(acc_, q4)); } } while (0)
#define MSQ(dst, src, lvl) do { const f32x16 acc_ = mm<4>(zero16(), SrcLds{SL(src)}, SrcLdsT{SL(src) + trQ}, prow, qrow, hh); float mx_ = 0.f; \
                _Pragma("unroll") for (int q4 = 0; q4 < 4; ++q4) st_bf4(SL(dst), prow, 32 * wq + 8 * q4 + 4 * hh, quad(acc_, q4)); \
                _Pragma("unroll") for (int q = 0; q < 16; ++q) mx_ = fmaxf(mx_, fabsf(acc_[q])); \
                mx_ = fmaxf(mx_, dpp_mov<0xB1>(mx_)); mx_ = fmaxf(mx_, dpp_mov<0x4E>(mx_)); mx_ = fmaxf(mx_, dpp_mov<0x141>(mx_)); mx_ = fmaxf(mx_, dpp_mov<0x140>(mx_)); \
                if ((lane & 15) == 0) atomicMax((unsigned*)(CNV + (lvl)), __float_as_uint(mx_)); } while (0)
#define CONVERGED(lvl) (__builtin_amdgcn_readfirstlane((int)(*(volatile LAS unsigned*)(CNV + (lvl)) < 0x39000000u)) != 0)
            if (grp == 0) T_UPDATE(2, 8, 5);
            else { MSQ(0, 5, 0); Keep = mm<4>(Keep, SrcLds{SL(3)}, SrcLdsT{SL(11) + trQ}, prow, qrow, hh); }
            MX_BAR();
            int ts = 2;
            if (!CONVERGED(0)) {
                if (grp == 0) T_UPDATE(8, 2, 0); else MSQ(5, 0, 1);
                MX_BAR();
                ts = 8;
                if (!CONVERGED(1)) {
                    if (grp == 0) T_UPDATE(2, 8, 5); else MSQ(0, 5, 2);
                    MX_BAR();
                    ts = 2;
                    if (!CONVERGED(2)) {
                        if (grp == 0) T_UPDATE(8, 2, 0);
                        MX_BAR();
                        ts = 8;
                    }
                }
            }
            if (grp == 0) Keep = mm<4>(Keep, SrcLdsT{SL(11) + trP}, SrcLdsT{SL(6) + trQ}, prow, qrow, hh);
            else { const f32x16 acc = mm<4>(zero16(), SrcLds{SL(10)}, SrcLds{SL(ts)}, prow, qrow, hh);
#pragma unroll
                for (int q4 = 0; q4 < 4; ++q4) st_bf4(SL(9), prow, 32 * wq + 8 * q4 + 4 * hh, -quad(acc, q4)); }
            MX_BAR();
            if (grp == 0) { Keep = mm<4>(Keep, SrcLds{SL(9)}, SrcLdsT{SL(7) + trQ}, prow, qrow, hh);
#pragma unroll
                for (int q4 = 0; q4 < 4; ++q4) { const f32x4 gc = *(const LAS f32x4*)(GCV + 32 * wq + 8 * q4 + 4 * hh);
#pragma unroll
                    for (int e = 0; e < 4; ++e) Keep[4 * q4 + e] *= gc[e]; } }
            else { Keep = mm<4>(Keep, SrcLds{SL(4)}, SrcLds{SL(9)}, prow, qrow, hh);
#pragma unroll
                for (int q4 = 0; q4 < 4; ++q4) *(LAS f32x4*)(SL(0) + prow * F32ROWB + (32 * wq + 8 * q4 + 4 * hh) * 4) = quad(Keep, q4); }
            MX_BAR();
            {
                const size_t gy = ga;
                PF_STORE();
                if (ch + 1 < SEQ / 64) ga += (size_t)64 * D;
                rR = *(const u32x4*)(Rg + ga); rK = *(const u32x4*)(Kg + ga); rV = *(const u32x4*)(Vg + ga);
                rRp = *(const u32x4*)(Rg + ga - D); rKp = *(const u32x4*)(Kg + ga - D); rVp = *(const u32x4*)(Vg + ga - D);
                const f32x4 y0 = *(const LAS f32x4*)(SL(0) + te * F32ROWB + jo * 32), y1 = *(const LAS f32x4*)(SL(0) + te * F32ROWB + jo * 32 + 16);
                f32x2 y[4] = {(f32x2){y0.x, y0.y}, (f32x2){y0.z, y0.w}, (f32x2){y1.x, y1.y}, (f32x2){y1.z, y1.w}}, gg[4];
                unpack4p(gpk, gg);
                const f32x2 sm2 = (y[0] + y[1]) + (y[2] + y[3]);
                const f32x2 mean = splat2(sum8(sm2.x + sm2.y) * (1.0f / 64.0f)); f32x2 sv2 = splat2(0.f);
#pragma unroll
                for (int i = 0; i < 4; ++i) { y[i] = y[i] - mean; sv2 = sv2 + y[i] * y[i]; }
                const f32x2 rstd = splat2(__builtin_amdgcn_rsqf(sum8(sv2.x + sv2.y) * (1.0f / 64.0f) + 64e-5f)), bo = splat2(BON[te]);
                const LAS float* cst = (const LAS float*)(L + SM_CST) + 8 * jo; f32x2 lg_[4], lb_[4]; CSTP(6, lg_); CSTP(7, lb_);
                f32x2 o[4];
#pragma unroll
                for (int i = 0; i < 4; ++i) o[i] = (y[i] * rstd * lg_[i] + lb_[i] + bo * vs[i]) * gg[i];
                { f32x2 u[4], cv[4], tp[4];
                  unpack4p(mU2, u); CSTP(10, tp);
#pragma unroll
                  for (int i = 0; i < 4; ++i) cv[i] = tp[i] * u[i];
                  unpack4p(mU1, u); { const f32x4 x0_ = *(const LAS f32x4*)(L + SM_C1 + 32 * jo), x1_ = *(const LAS f32x4*)(L + SM_C1 + 32 * jo + 16); tp[0] = (f32x2){x0_.x, x0_.y}; tp[1] = (f32x2){x0_.z, x0_.w}; tp[2] = (f32x2){x1_.x, x1_.y}; tp[3] = (f32x2){x1_.z, x1_.w}; }
#pragma unroll
                  for (int i = 0; i < 4; ++i) cv[i] = cv[i] + tp[i] * u[i];
                  unpack4p(mU0, u); CSTP(11, tp);
#pragma unroll
                  for (int i = 0; i < 4; ++i) cv[i] = cv[i] + tp[i] * u[i];
                  unpack4p(mGB, u); unpack4p(mGR, tp);
#pragma unroll
                  for (int i = 0; i < 4; ++i) o[i] = u[i] * cv[i] + tp[i] * o[i]; }
                u32x4 w; w.x = cvt_pk2(o[0]); w.y = cvt_pk2(o[1]); w.z = cvt_pk2(o[2]); w.w = cvt_pk2(o[3]);
                *(u32x4*)(Yg + gy) = w;
                if (grp == 0) {
#pragma unroll
                    for (int q4 = 0; q4 < 4; ++q4) st_bf4(SL(HBS), prow, 32 * wq + 8 * q4 + 4 * hh, quad(Keep, q4)); }
            }
            MX_BAR();
        }
    }
#undef SL
#undef MX_BAR
#undef STP
#undef CSTP
#undef MM_STORE
#undef T_UPDATE
#undef MM_STORE_G
#undef MM_STORE_MASK
#undef MSQ
#undef CONVERGED
#undef PF_LOAD
#undef PF_STORE
}

struct EpiWout {
    static constexpr bool PERM = true, F8 = false;
    const float* x; bf16_t* h; unsigned char* h8;
    __device__ __forceinline__ void load_q(f32x4 (&xv)[2][2][2], int q, int row0, int col0) const {
#pragma unroll
        for (int mm = 0; mm < 2; ++mm) { const size_t off = (size_t)(row0 + (q >> 1) * 128 + ((q & 1) * 2 + mm) * 16) * D + col0;
#pragma unroll
            for (int bj = 0; bj < 2; ++bj) { xv[mm][bj][0] = __builtin_nontemporal_load((const f32x4*)(x + off + bj * 128)); xv[mm][bj][1] = __builtin_nontemporal_load((const f32x4*)(x + off + bj * 128 + 4)); } }
    }
    __device__ __forceinline__ void store_q(const f32x4 (&xv)[2][2][2], const f32x4 (&acc)[2][2][4][2], int q, int row0, int col0) const {
        const int ai = q >> 1;
#pragma unroll
        for (int mm = 0; mm < 2; ++mm) { const int m = (q & 1) * 2 + mm; const size_t off = (size_t)(row0 + ai * 128 + m * 16) * D + col0;
#pragma unroll
            for (int bj = 0; bj < 2; ++bj) { const f32x4 v0 = xv[mm][bj][0] + acc[ai][bj][m][0], v1 = xv[mm][bj][1] + acc[ai][bj][m][1];
                u32x4 w; w.x = cvt_pk_bf16(v0[0], v0[1]); w.y = cvt_pk_bf16(v0[2], v0[3]); w.z = cvt_pk_bf16(v1[0], v1[1]); w.w = cvt_pk_bf16(v1[2], v1[3]);
                *(u32x4*)(h + off + bj * 128) = w;
                u32x2 w8; w8.x = cvt4_fp8(v0[0], v0[1], v0[2], v0[3]); w8.y = cvt4_fp8(v1[0], v1[1], v1[2], v1[3]); *(u32x2*)(h8 + off + bj * 128) = w8; } }
    }
    __device__ __forceinline__ void operator()(const f32x4 (&acc)[2][2][4][2], const pg8::Unit& u, int wr, int wc, int fr, int fq) const {
        const int row0 = u.pm * 256 + wr * 64 + fr, col0 = u.pn * 256 + wc * 32 + 8 * fq;
        f32x4 xa[2][2][2], xb[2][2][2];
        load_q(xa, 0, row0, col0); load_q(xb, 1, row0, col0);
        store_q(xa, acc, 0, row0, col0); load_q(xa, 2, row0, col0);
        store_q(xb, acc, 1, row0, col0); load_q(xb, 3, row0, col0);
        store_q(xa, acc, 2, row0, col0);
        store_q(xb, acc, 3, row0, col0);
    }
};

__device__ __forceinline__ void split8(const f32x4 a, const f32x4 b, bf16x8& hi, bf16x8& lo) {
    float f[8] = {a.x, a.y, a.z, a.w, b.x, b.y, b.z, b.w}; unsigned h[4], l[4];
#pragma unroll
    for (int j = 0; j < 4; ++j) { h[j] = cvt_pk_bf16(f[2 * j], f[2 * j + 1]); l[j] = cvt_pk_bf16(f[2 * j] - bf_lo(h[j]), f[2 * j + 1] - bf_hi(h[j])); }
    const u32x4 hv = {h[0], h[1], h[2], h[3]}, lv = {l[0], l[1], l[2], l[3]};
    hi = __builtin_bit_cast(bf16x8, hv); lo = __builtin_bit_cast(bf16x8, lv);
}
__device__ __forceinline__ void phase_router(const Ctx& C) {
    LAS unsigned char* WL = C.lds;
    LAS unsigned* lcnt = (LAS unsigned*)(C.lds + TAB_OFF); LAS unsigned* lbase = lcnt + 128; LAS unsigned short* lent = (LAS unsigned short*)(lbase + 128);
    const bf16_t* hbuf = WSP(bf16_t, WS_HB); float* RL = WSP(float, WS_RL); float* GL = (float*)C.out; LAS float* lrstd = (LAS float*)(lent + 1024); LAS float* lgate = lrstd + 256;
    unsigned* gcnt = WSP(unsigned, WS_CNT); int* LIST = WSP(int, WS_R6);
    const float* rb = C.in[I_RB];
    const int lane = C.lane, r = lane & 31, hh = lane >> 5;
    { const u32x4* src = WSP(const u32x4, WS_RWG) + C.tid; u32x4 t[16];
#pragma unroll
      for (int i = 0; i < 16; ++i) t[i] = src[512 * i];
#pragma unroll
      for (int i = 0; i < 16; ++i) ((LAS u32x4*)WL)[C.tid + 512 * i] = t[i]; }
    __syncthreads();
    for (int blk = C.bid; blk < T / 256; blk += C.G) {
        if (C.tid < 128) lcnt[C.tid] = 0u;
        __syncthreads();
        const int t = blk * 256 + C.wave * 32 + r;
        const u32x4* hp = (const u32x4*)(hbuf + (size_t)t * D) + hh;
        f32x16 acc;
#pragma unroll
        for (int q = 0; q < 16; ++q) acc[q] = 0.f;
        float ss = 0.f;
#pragma unroll 8
        for (int s = 0; s < 64; ++s) {
            const u32x4 tv = hp[2 * s]; float f[8]; unpack8(tv, f);
#pragma unroll
            for (int j = 0; j < 8; ++j) ss += f[j] * f[j];
            const bf16x8 th = __builtin_bit_cast(bf16x8, tv);
            const bf16x8 whi = *(const LAS bf16x8*)(WL + s * 1024 + r * 32 + hh * 16), wlo = *(const LAS bf16x8*)(WL + 65536 + s * 1024 + r * 32 + hh * 16);
            acc = __builtin_amdgcn_mfma_f32_32x32x16_bf16(whi, th, acc, 0, 0, 0);
            acc = __builtin_amdgcn_mfma_f32_32x32x16_bf16(wlo, th, acc, 0, 0, 0);
        }
        ss += __shfl_xor(ss, 32);
        const float rstd = rsqrtf(ss * (1.f / D) + 1e-5f);
        float lg[32];
#pragma unroll
        for (int q = 0; q < 16; ++q) { const float mine = acc[q], other = __shfl_xor(mine, 32); const int e0 = (q & 3) + 8 * (q >> 2);
            lg[e0 + 4 * hh] = mine; lg[e0 + 4 * (hh ^ 1)] = other; }
#pragma unroll
        for (int e = 0; e < 32; ++e) lg[e] = lg[e] * rstd + rb[e];
        int ti[4]; float tv[4];
#pragma unroll
        for (int k = 0; k < 4; ++k) { float best = -3.0e38f; int bi = 0;
#pragma unroll
            for (int e = 0; e < 32; ++e) { const bool take = lg[e] > best; best = take ? lg[e] : best; bi = take ? e : bi; }
            ti[k] = bi; tv[k] = best;
#pragma unroll
            for (int e = 0; e < 32; ++e) lg[e] = (e == bi) ? -3.0e38f : lg[e]; }
        const float e1 = __expf(tv[1] - tv[0]), e2 = __expf(tv[2] - tv[0]), e3 = __expf(tv[3] - tv[0]); const float inv = 1.0f / (1.0f + e1 + e2 + e3);
        if (hh == 0) {
            const int tl = C.wave * 32 + r;
            *(LAS f32x4*)(lgate + tl * 4) = (f32x4){inv, e1 * inv, e2 * inv, e3 * inv};
#pragma unroll
            for (int k = 0; k < 4; ++k) { const unsigned pos = atomicAdd((unsigned*)&lcnt[k * 32 + ti[k]], 1u); lent[tl * 4 + k] = (unsigned short)(((unsigned)ti[k] << 8) | pos); }
            lrstd[tl] = rstd;
        }
        __syncthreads();
        if (C.tid < 128) { const unsigned n = lcnt[C.tid]; lbase[C.tid] = n ? __hip_atomic_fetch_add(&gcnt[C.tid], n, __ATOMIC_RELAXED, __HIP_MEMORY_SCOPE_AGENT) : 0u; }
        __syncthreads();
        for (int idx = C.tid; idx < 1024; idx += 512) { const int tl = idx >> 2, k = idx & 3; const unsigned ent = lent[idx], e = ent >> 8, pos = ent & 0xffu;
            const size_t li = (size_t)(k * 32 + e) * LISTCAP + lbase[k * 32 + e] + pos; LIST[li] = blk * 256 + tl; RL[li] = lrstd[tl]; GL[li] = lgate[idx]; }
        __syncthreads();
    }
}

struct MoeSched {
    int G, c, NT, n_tiles;     const LAS int* tstart; const LAS int* texp; const LAS unsigned* cnt; const int* list;
    __device__ __forceinline__ bool next(int i, pg8::Unit& u) const {
        const int L = i * G + c, tile = L / NT; if (tile >= n_tiles) return false;
        u.pn = L - tile * NT; u.e = texp[tile]; u.rt = tile - tstart[u.e]; u.pm = tile; u.at = tile; u.bt = u.e * NT + u.pn; return true;
    }
    __device__ __forceinline__ int token(const pg8::Unit& u, int row) const { const int idx = u.rt * 256 + row; return list[(size_t)u.e * LISTCAP + (idx < (int)cnt[u.e] ? idx : 0)]; }
};
__device__ __forceinline__ void moe_tables(const Ctx& C, int k, MoeSched& S, int NT, int set, int rot) {
    LAS int* tstart = (LAS int*)(C.lds + TAB_OFF + set * 2048); LAS unsigned* cnt = (LAS unsigned*)(C.lds + TAB_OFF + set * 2048 + 160); LAS int* texp = (LAS int*)(C.lds + TAB_OFF + set * 2048 + 320);
    const unsigned* gcnt = WSP(unsigned, WS_CNT);
    __syncthreads();
    if (C.tid < 32) cnt[C.tid] = gcnt[k * 32 + C.tid];
    __syncthreads();
    if (C.tid < 64) {
        const int e = C.tid, n = e < 32 ? ((int)cnt[e & 31] + 255) >> 8 : 0; int incl = n;
#pragma unroll
        for (int o = 1; o < 32; o <<= 1) { const int t = __shfl_up(incl, o); if (e >= o) incl += t; }
        if (e < 32) { const int a = incl - n; tstart[e] = a; for (int j = 0; j < n; ++j) texp[a + j] = e; if (e == 31) tstart[32] = incl; }
    }
    __syncthreads();
    { const int vcu = (C.G % 8 == 0) ? (C.bid % 8) * (C.G / 8) + C.bid / 8 : C.bid;
      S.G = C.G; S.c = (vcu + rot) % C.G; S.NT = NT; } S.n_tiles = tstart[32]; S.tstart = tstart; S.texp = texp; S.cnt = cnt; S.list = WSP(int, WS_R6) + (size_t)k * 32 * LISTCAP;
}
struct EpiMoeA {
    static constexpr bool PERM = true, F8 = true;
    unsigned char* ACT; const float* b1; const float* rl; const LAS unsigned* cnt;
    __device__ __forceinline__ void operator()(const f32x4 (&acc)[2][2][4][2], const pg8::Unit& u, int wr, int wc, int fr, int fq) const {
        const int row0 = u.pm * 256 + wr * 64 + fr, cl = 128 * u.pn + wc * 32 + 8 * fq;
        const float* bg = b1 + (size_t)u.e * 2048 + cl; f32x4 bgl[2], bln[2];
#pragma unroll
        for (int n = 0; n < 2; ++n) { bgl[n] = *(const f32x4*)(bg + 4 * n); bln[n] = *(const f32x4*)(bg + 1024 + 4 * n); }
        float rs[2][4]; const int n_e = (int)cnt[u.e];
#pragma unroll
        for (int ai = 0; ai < 2; ++ai)
#pragma unroll
            for (int m = 0; m < 4; ++m) { const int idx = u.rt * 256 + ai * 128 + wr * 64 + m * 16 + fr; rs[ai][m] = rl[(size_t)u.e * LISTCAP + (idx < n_e ? idx : 0)] * 0.015625f; }
#pragma unroll
        for (int ai = 0; ai < 2; ++ai)
#pragma unroll
            for (int m = 0; m < 4; ++m) { f32x4 o[2];
#pragma unroll
                for (int n = 0; n < 2; ++n) { const f32x4 gl = acc[ai][0][m][n] * rs[ai][m] + bgl[n], ln = acc[ai][1][m][n] * rs[ai][m] + bln[n];
#pragma unroll
                    for (int j = 0; j < 4; j += 2) {
                        const f32x2 gv = (f32x2){fminf(gl[j], 7.0f), fminf(gl[j + 1], 7.0f)}, lv = (f32x2){fminf(fmaxf(ln[j], -7.0f), 7.0f), fminf(fmaxf(ln[j + 1], -7.0f), 7.0f)};
                        const f32x2 t = gv * (f32x2){-2.45546696f, -2.45546696f};
                        const f32x2 e = (f32x2){__builtin_amdgcn_exp2f(t.x), __builtin_amdgcn_exp2f(t.y)} + (f32x2){1.0f, 1.0f};
                        const f32x2 sg = (f32x2){fast_rcp(e.x), fast_rcp(e.y)};
                        const f32x2 r = (gv * sg) * (lv + (f32x2){1.0f, 1.0f});
                        o[n][j] = r.x; o[n][j + 1] = r.y; } }
                u32x2 w; w.x = cvt4_fp8(o[0][0], o[0][1], o[0][2], o[0][3]); w.y = cvt4_fp8(o[1][0], o[1][1], o[1][2], o[1][3]);
                *(u32x2*)(ACT + (size_t)(row0 + ai * 128 + m * 16) * D + cl) = w; }
    }
};
struct EpiMoeB {
    static constexpr bool PERM = true, F8 = true;
    const bf16_t* hs; bf16_t* h; const float* b2; const float* gl; const int* list; const LAS unsigned* cnt;
    __device__ __forceinline__ void operator()(const f32x4 (&acc)[2][2][4][2], const pg8::Unit& u, int wr, int wc, int fr, int fq) const {
        const int col0 = u.pn * 256 + wc * 32 + 8 * fq; const int n_e = (int)cnt[u.e];
        int tok[2][4]; float gt[2][4];
#pragma unroll
        for (int ai = 0; ai < 2; ++ai)
#pragma unroll
            for (int m = 0; m < 4; ++m) { const int idx = u.rt * 256 + ai * 128 + wr * 64 + m * 16 + fr; const size_t li = (size_t)u.e * LISTCAP + (idx < n_e ? idx : 0); tok[ai][m] = list[li]; const float g = gl[li]; gt[ai][m] = idx < n_e ? g : -1.0f; }
        f32x4 bv[2][2];
#pragma unroll
        for (int bj = 0; bj < 2; ++bj)
#pragma unroll
            for (int n = 0; n < 2; ++n) bv[bj][n] = *(const f32x4*)(b2 + (size_t)u.e * D + col0 + bj * 128 + 4 * n);
#define MB_LOAD(hv, q) do { _Pragma("unroll") for (int mm = 0; mm < 2; ++mm) _Pragma("unroll") for (int bj = 0; bj < 2; ++bj) \
            hv[mm][bj] = *(const u32x4*)(hs + (size_t)tok[(q) >> 1][((q) & 1) * 2 + mm] * D + col0 + bj * 128); } while (0)
#define MB_STORE(hv, q) do { _Pragma("unroll") for (int mm = 0; mm < 2; ++mm) { const int ai = (q) >> 1, m = ((q) & 1) * 2 + mm; if (gt[ai][m] > 0.f) { bf16_t* hp = h + (size_t)tok[ai][m] * D + col0; \
            _Pragma("unroll") for (int bj = 0; bj < 2; ++bj) { float f[8]; unpack8(hv[mm][bj], f); const f32x4 d0 = (acc[ai][bj][m][0] * 0.015625f + bv[bj][0]) * gt[ai][m], d1 = (acc[ai][bj][m][1] * 0.015625f + bv[bj][1]) * gt[ai][m]; \
                u32x4 w; w.x = cvt_pk_bf16(f[0] + d0[0], f[1] + d0[1]); w.y = cvt_pk_bf16(f[2] + d0[2], f[3] + d0[3]); w.z = cvt_pk_bf16(f[4] + d1[0], f[5] + d1[1]); w.w = cvt_pk_bf16(f[6] + d1[2], f[7] + d1[3]); \
                *(u32x4*)(hp + bj * 128) = w; } } } } while (0)
        u32x4 ha[2][2], hb[2][2];
        MB_LOAD(ha, 0); MB_LOAD(hb, 1);
        MB_STORE(ha, 0); MB_LOAD(ha, 2);
        MB_STORE(hb, 1); MB_LOAD(hb, 3);
        MB_STORE(ha, 2);
        MB_STORE(hb, 3);
#undef MB_LOAD
#undef MB_STORE
    }
};

__device__ __forceinline__ void phase_final(const Ctx& C) {
    const int gw = C.bid * 8 + C.wave, NGW = C.G * 8; const float* g = C.in[I_NFIN]; const bf16_t* hb = WSP(bf16_t, WS_R1);
    for (int m = gw; m < T; m += 2 * NGW) {
        const int m2 = m + NGW < T ? m + NGW : m;
        const u32x2* xa = (const u32x2*)(hb + (size_t)m * D) + C.lane; const u32x2* xb = (const u32x2*)(hb + (size_t)m2 * D) + C.lane;
        u32x2 wa[4], wb[4];
#pragma unroll
        for (int j = 0; j < 4; ++j) { wa[j] = xa[64 * j]; wb[j] = xb[64 * j]; }
        f32x4 va[4], vb[4]; float sa = 0.f, sb = 0.f;
#pragma unroll
        for (int j = 0; j < 4; ++j) { va[j] = (f32x4){bf_lo(wa[j].x), bf_hi(wa[j].x), bf_lo(wa[j].y), bf_hi(wa[j].y)}; vb[j] = (f32x4){bf_lo(wb[j].x), bf_hi(wb[j].x), bf_lo(wb[j].y), bf_hi(wb[j].y)};
            sa += (va[j].x * va[j].x + va[j].y * va[j].y) + (va[j].z * va[j].z + va[j].w * va[j].w); sb += (vb[j].x * vb[j].x + vb[j].y * vb[j].y) + (vb[j].z * vb[j].z + vb[j].w * vb[j].w); }
#pragma unroll
        for (int o = 1; o < 64; o <<= 1) { sa += __shfl_xor(sa, o); sb += __shfl_xor(sb, o); }
        const float ra = rsqrtf(sa * (1.f / D) + 1e-5f), rb = rsqrtf(sb * (1.f / D) + 1e-5f);
        f32x4* oa = (f32x4*)(C.out + (size_t)m * D) + C.lane; f32x4* ob = (f32x4*)(C.out + (size_t)m2 * D) + C.lane;
#pragma unroll
        for (int j = 0; j < 4; ++j) { const f32x4 gv = ((const f32x4*)g)[C.lane + 64 * j]; __builtin_nontemporal_store(va[j] * ra * gv, oa + 64 * j); __builtin_nontemporal_store(vb[j] * rb * gv, ob + 64 * j); }
    }
}

__global__ void __launch_bounds__(512, 2) fwd(Args args) {
    extern __shared__ __attribute__((aligned(16))) unsigned char lds_raw[];
    Ctx C; C.in = args.in; C.out = args.out; C.ws = args.ws; C.lds = (LAS unsigned char*)lds_raw;
    C.tid = threadIdx.x; C.lane = C.tid & 63; C.wave = __builtin_amdgcn_readfirstlane(C.tid >> 6); C.G = gridDim.x; C.bid = blockIdx.x;
    volatile LAS unsigned* MISC = (volatile LAS unsigned*)(C.lds + MISC_OFF);
    if (C.tid < 4) MISC[C.tid] = 0u;
    __syncthreads();
    const int lo = args.ph_lo, hi = args.ph_hi;
    XcdBarrier bar; bar.bar = (unsigned*)(C.ws + WS_CTL); bar.x = 0; bar.st = MISC;
    if (hi - lo > 1) bar = xcd_barrier_post((unsigned*)(C.ws + WS_CTL), MISC);
#define IN(k) (lo <= (k) && (k) < hi)
#define SEAM(k) do { if (IN(k) && IN((k) + 1)) xcd_barrier(bar); } while (0)

    if (IN(PH_PREP)) { phase_prep(C); } SEAM(PH_PREP);

    if (IN(PH_GEMM1)) {
        { pg8::StaticOrderOff S; S.init(T, (NF8 - F8LO) * 256, C.G, C.bid); S.off = F8LO; EpiP1T<true> E{C.ws};
          pg8::gemm_phase<EpiP1T<true>, pg8::StaticOrderOff, false>(C.lds, (const bf16_t*)((const unsigned char*)C.out + DO_XN8), (const bf16_t*)((const unsigned char*)C.out + DO_WIN8), D, S, E); }
        { pg8::StaticOrder S; S.init(T, F8LO * 256, C.G, C.bid); EpiP1T<false> E{C.ws};
          pg8::gemm_phase<EpiP1T<false>, pg8::StaticOrder, false>(C.lds, WSP(bf16_t, WS_R0), WSP(bf16_t, WS_WINT), D, S, E); }
        { pg8::StaticOrderOff S; S.init(T, N1 - NF8 * 256, C.G, C.bid); S.off = NF8; EpiP1T<false> E{C.ws};
          pg8::gemm_phase<EpiP1T<false>, pg8::StaticOrderOff, false>(C.lds, WSP(bf16_t, WS_R0), WSP(bf16_t, WS_WINT), D, S, E); }
    } SEAM(PH_GEMM1);

    if (IN(PH_LORA)) { phase_lact(C); phase_cvt_experts(C); } SEAM(PH_LORA);

    if (IN(PH_SCAN)) { phase_mixer(C); } SEAM(PH_SCAN);


    if (IN(PH_WOUT)) {
        pg8::StaticOrder S; S.init(T, D, C.G, C.bid);
        EpiWout E{C.in[I_X], WSP(bf16_t, WS_HB), WSP(unsigned char, WS_H8)};
        pg8::gemm_phase<EpiWout, pg8::StaticOrder, false>(C.lds, (const bf16_t*)C.out, WSP(bf16_t, WS_WOUTT), D, S, E);
    } SEAM(PH_WOUT);

    if (IN(PH_ROUTER)) { phase_router(C); } SEAM(PH_ROUTER);

#define ACT_BUF(kk) (WSP(unsigned char, WS_R2) + (size_t)((kk) & 1) * (76 * MiB))
#define MOE_A(kk, set, rot) do { MoeSched S; moe_tables(C, kk, S, 8, set, rot); EpiMoeA E{ACT_BUF(kk), C.in[I_EB1], WSP(float, WS_RL) + (size_t)(kk) * 32 * LISTCAP, S.cnt}; \
        pg8::gemm_phase<EpiMoeA, MoeSched, true>(C.lds, WSP(bf16_t, WS_H8), WSP(bf16_t, WS_R0), D, S, E); } while (0)
#define MOE_B(kk, set, rotv) do { MoeSched S; moe_tables(C, kk, S, 4, set, 0); EpiMoeB E{(kk) == 0 ? WSP(bf16_t, WS_HB) : WSP(bf16_t, WS_R1), WSP(bf16_t, WS_R1), C.in[I_EB2], (const float*)C.out + (size_t)(kk) * 32 * LISTCAP, S.list, S.cnt}; \
        pg8::gemm_phase<EpiMoeB, MoeSched, false>(C.lds, (const bf16_t*)ACT_BUF(kk), (const bf16_t*)((const unsigned char*)C.out + DO_W2T), D, S, E); rotv = C.G - (S.n_tiles * 4) % C.G; } while (0)
    if (IN(PH_MOE_0)) { MOE_A(0, 0, 0); } SEAM(PH_MOE_0);
    if (IN(PH_MOE_1)) { int rot = 0; MOE_B(0, 0, rot); MOE_A(1, 1, rot); } SEAM(PH_MOE_1);
    if (IN(PH_MOE_2)) { int rot = 0; MOE_B(1, 0, rot); MOE_A(2, 1, rot); } SEAM(PH_MOE_2);
    if (IN(PH_MOE_3)) { int rot = 0; MOE_B(2, 0, rot); MOE_A(3, 1, rot); } SEAM(PH_MOE_3);
    if (IN(PH_MOE_4)) { int rot = 0; MOE_B(3, 0, rot); (void)rot; } SEAM(PH_MOE_4);

    if (IN(PH_FINAL)) { phase_final(C); }
#undef IN
#undef SEAM
}

extern "C" void kernel_launch(void* const* d_in, const int* in_sizes, int n_in, void* d_out, int out_size, void* d_ws, size_t ws_size, hipStream_t stream) {
    static int grid = 0;
    if (grid == 0) {
        if (n_in != 24 || in_sizes[0] != T * D || out_size != T * D || ws_size < WS_END) { fprintf(stderr, "kernel_launch: unexpected shapes (n_in %d, in0 %d, out %d, ws %zu)\n", n_in, n_in > 0 ? in_sizes[0] : -1, out_size, ws_size); grid = -1; return; }
        int dev = 0, cus = 0, per_cu = 0;
        if (hipGetDevice(&dev) != hipSuccess || hipDeviceGetAttribute(&cus, hipDeviceAttributeMultiprocessorCount, dev) != hipSuccess) { grid = -1; return; }
        if (hipFuncSetAttribute((const void*)fwd, hipFuncAttributeMaxDynamicSharedMemorySize, LDS_BYTES) != hipSuccess) { fprintf(stderr, "kernel_launch: hipFuncSetAttribute failed\n"); grid = -1; return; }
        if (hipOccupancyMaxActiveBlocksPerMultiprocessor(&per_cu, (const void*)fwd, 512, LDS_BYTES) != hipSuccess || per_cu < 1) fprintf(stderr, "kernel_launch: occupancy query says %d\n", per_cu);
        (void)hipGetLastError();
        grid = cus;
    }
    if (grid < 0) return;
    (void)hipMemsetAsync((char*)d_ws + WS_CTL, 0, CTL_ZERO_BYTES, stream);
    Args a{};
    for (int i = 0; i < 24; ++i) a.in[i] = (const float*)d_in[i];
    a.out = (float*)d_out; a.ws = (unsigned char*)d_ws;
#if ONE_LAUNCH
    a.ph_lo = 0; a.ph_hi = NPH;
    hipLaunchKernelGGL(fwd, dim3(grid), dim3(512), LDS_BYTES, stream, a);
#else
    for (int p = 0; p < NPH; ++p) { a.ph_lo = p; a.ph_hi = p + 1; hipLaunchKernelGGL(fwd, dim3(grid), dim3(512), LDS_BYTES, stream, a); }
#endif
}
```
